# Optimizing an MI355X kernel written in HIP

```python
import math
import jax, jax.numpy as jnp
from jax import lax
import numpy as np

D_MODEL = 1024
BATCH = 2
SEQ = 8192
DEPTH = 2

D_MIX = D_MODEL
D_HYENA = D_MIX // 2
D_ATTN = D_MIX - D_HYENA
N_DIFF_HEADS = 4
DIFF_V_DIM = D_ATTN // N_DIFF_HEADS
DIFF_QK_DIM = DIFF_V_DIM // 2
D_QK = N_DIFF_HEADS * 2 * DIFF_QK_DIM
HYENA_ORDER = 2
HY_PROJ = (HYENA_ORDER + 1) * D_HYENA
D_IN = HY_PROJ + D_HYENA + 2 * D_QK + D_ATTN + D_ATTN
HYENA_EMB_DIM = 33
HYENA_FILTER_ORDER = 64
SHORT_CONV = 3
DECAY_TARGET = 1e-2
FAST_DECAY_PCT = 0.3
SLOW_DECAY_PCT = 1.5
ROPE_THETA = 10000.0
Q_BLOCK = 128
NORM_EPS = 1e-6
SUBLN_EPS = 1e-5

kernel_name = "hybrid_hyena_diffattn_encoder"


def rmsnorm(x, g, eps):
    xf = x.astype(jnp.float32)
    y = xf * lax.rsqrt(jnp.mean(xf * xf, axis=-1, keepdims=True) + eps)
    return (y * g.astype(jnp.float32)).astype(x.dtype)


def rope_tables(S, dim):
    inv_freq = 1.0 / (ROPE_THETA ** (jnp.arange(0, dim, 2, dtype=jnp.float32) / dim))
    pos = jnp.arange(S, dtype=jnp.float32)
    ang = pos[:, None] * inv_freq[None, :]
    ang = jnp.concatenate([ang, ang], axis=-1)
    return jnp.cos(ang), jnp.sin(ang)


def apply_rope(t, cos, sin):
    half = t.shape[-1] // 2
    rot = jnp.concatenate([-t[..., half:], t[..., :half]], axis=-1)
    c = cos[None, :, None, None, :]
    s = sin[None, :, None, None, :]
    return (t * c + rot * s).astype(t.dtype)


def short_conv_centered(u, w, b):
    up = jnp.pad(u, ((0, 0), (1, 1), (0, 0)))
    return up[:, :-2] * w[0] + up[:, 1:-1] * w[1] + up[:, 2:] * w[2] + b


def hyena_filter_spectra(L, w1, b1, w2, b2, w3, b3, freq, w4):
    f32 = jnp.float32
    t = jnp.linspace(0.0, 1.0, L, dtype=f32)[:, None]
    bands = (HYENA_EMB_DIM - 1) // 2
    wpos = 2.0 * math.pi * jnp.arange(L, dtype=f32) / L
    fb = jnp.linspace(1e-4, bands - 1, bands, dtype=f32)
    ph = wpos[:, None] * fb[None, :]
    z = jnp.concatenate([t, jnp.cos(ph), -jnp.sin(ph)], axis=-1)
    fr = freq.astype(f32)
    hdn = jnp.sin(fr * (z @ w1.astype(f32) + b1.astype(f32)))
    hdn = jnp.sin(fr * (hdn @ w2.astype(f32) + b2.astype(f32)))
    hdn = jnp.sin(fr * (hdn @ w3.astype(f32) + b3.astype(f32)))
    hf = (hdn @ w4.astype(f32)).reshape(L, 2 * HYENA_ORDER, D_HYENA)
    max_decay = math.log(DECAY_TARGET) / FAST_DECAY_PCT
    min_decay = math.log(DECAY_TARGET) / SLOW_DECAY_PCT
    deltas = jnp.linspace(min_decay, max_decay, D_HYENA, dtype=f32)
    decay = jnp.exp(-t * jnp.abs(deltas)[None, :])
    hf = hf * decay[:, None, :]
    h_fwd = hf[:, :HYENA_ORDER]
    h_bwd = hf[:, HYENA_ORDER:]
    k = jnp.concatenate([h_fwd, jnp.zeros((1, HYENA_ORDER, D_HYENA), f32), h_bwd[:0:-1]], axis=0)
    k = k / jnp.sum(jnp.abs(k), axis=0, keepdims=True)
    return jnp.fft.rfft(k, axis=0)


def fft_conv(u, kf, dskip):
    L = u.shape[1]
    U = jnp.fft.rfft(u, n=2 * L, axis=1)
    y = jnp.fft.irfft(U * kf[None], n=2 * L, axis=1)[:, :L]
    return y + u * dskip


def hyena_branch(hy_in, conv_w, conv_b, kf, filt_bias):
    f32 = jnp.float32
    c = short_conv_centered(hy_in.astype(f32), conv_w.astype(f32), conv_b.astype(f32))
    pv, px1, px2 = jnp.split(c, 3, axis=-1)
    dsk = filt_bias.astype(f32)
    z = px1 * fft_conv(pv, kf[:, 0], dsk[0])
    z = px2 * fft_conv(z, kf[:, 1], dsk[1])
    return z.astype(hy_in.dtype)


def diff_attention(q, k, v, lam):
    B, S, H, _, dq = q.shape
    nb = S // Q_BLOCK
    scale = dq ** -0.5
    qb = q.reshape(B, nb, Q_BLOCK, H, 2, dq).transpose(1, 0, 2, 3, 4, 5)

    def block(qi):
        s = jnp.einsum('bqhcd,bkhcd->bhcqk', qi, k, preferred_element_type=jnp.float32) * scale
        p = jax.nn.softmax(s, axis=-1)
        a = p[:, :, 0] - lam * p[:, :, 1]
        return jnp.einsum('bhqk,bkhe->bqhe', a.astype(v.dtype), v)

    o = lax.map(block, qb)
    return o.transpose(1, 0, 2, 3, 4).reshape(B, S, H, v.shape[-1])


def diff_attn_branch(q, k, v, cos, sin, lq1, lk1, lq2, lk2, subg, lam_init):
    B, S, _ = q.shape
    qh = apply_rope(q.reshape(B, S, N_DIFF_HEADS, 2, DIFF_QK_DIM), cos, sin)
    kh = apply_rope(k.reshape(B, S, N_DIFF_HEADS, 2, DIFF_QK_DIM), cos, sin)
    vh = v.reshape(B, S, N_DIFF_HEADS, DIFF_V_DIM)
    f32 = jnp.float32
    lam = (jnp.exp(jnp.sum(lq1.astype(f32) * lk1.astype(f32)))
           - jnp.exp(jnp.sum(lq2.astype(f32) * lk2.astype(f32))) + lam_init)
    o = diff_attention(qh, kh, vh, lam)
    o = rmsnorm(o, subg, SUBLN_EPS) * (1.0 - lam_init)
    return o.reshape(B, S, D_ATTN).astype(q.dtype)


def setup_inputs(seed: int = 0) -> dict:
    key = jax.random.key(seed)
    ks = jax.random.split(key, 24)
    n = jax.random.normal
    f32 = jnp.float32
    E, R = HYENA_EMB_DIM, HYENA_FILTER_ORDER
    return {
        "x": n(ks[0], (BATCH, SEQ, D_MODEL), f32),
        "norm_g": 1.0 + 0.02 * n(ks[1], (DEPTH, D_MODEL), f32),
        "w_in": n(ks[2], (DEPTH, D_MODEL, D_IN), f32) * D_MODEL ** -0.5,
        "conv_w": n(ks[3], (DEPTH, SHORT_CONV, HY_PROJ), f32) * SHORT_CONV ** -0.5,
        "conv_b": 0.05 * n(ks[4], (DEPTH, HY_PROJ), f32),
        "filt_w1": n(ks[5], (DEPTH, E, R), f32) * E ** -0.5,
        "filt_b1": n(ks[6], (DEPTH, R), f32) * E ** -0.5,
        "filt_w2": n(ks[7], (DEPTH, R, R), f32) * R ** -0.5,
        "filt_b2": n(ks[8], (DEPTH, R), f32) * R ** -0.5,
        "filt_w3": n(ks[9], (DEPTH, R, R), f32) * R ** -0.5,
        "filt_b3": n(ks[10], (DEPTH, R), f32) * R ** -0.5,
        "filt_freq": 1.0 + 0.01 * n(ks[11], (DEPTH, R), f32),
        "filt_w4": n(ks[12], (DEPTH, R, 2 * HYENA_ORDER * D_HYENA), f32) * R ** -0.5,
        "filt_bias": n(ks[13], (DEPTH, HYENA_ORDER, D_HYENA), f32),
        "lam_q1": 0.1 * n(ks[14], (DEPTH, DIFF_QK_DIM), f32),
        "lam_k1": 0.1 * n(ks[15], (DEPTH, DIFF_QK_DIM), f32),
        "lam_q2": 0.1 * n(ks[16], (DEPTH, DIFF_QK_DIM), f32),
        "lam_k2": 0.1 * n(ks[17], (DEPTH, DIFF_QK_DIM), f32),
        "subln_g": 1.0 + 0.02 * n(ks[18], (DEPTH, DIFF_V_DIM), f32),
        "w_out": n(ks[19], (DEPTH, D_MIX, D_MODEL), f32) * D_MIX ** -0.5,
        "final_g": 1.0 + 0.02 * n(ks[20], (D_MODEL,), f32),
    }


def reference(x, norm_g, w_in, conv_w, conv_b, filt_w1, filt_b1, filt_w2, filt_b2, filt_w3, filt_b3,
              filt_freq, filt_w4, filt_bias, lam_q1, lam_k1, lam_q2, lam_k2, subln_g, w_out, final_g):
    B, S, _ = x.shape
    cos, sin = rope_tables(S, DIFF_QK_DIM)
    o_hg = HY_PROJ
    o_q = o_hg + D_HYENA
    o_k = o_q + D_QK
    o_v = o_k + D_QK
    o_ag = o_v + D_ATTN
    h = x
    for layer in range(DEPTH):
        lam_init = 0.8 - 0.6 * math.exp(-0.3 * layer)
        u = rmsnorm(h, norm_g[layer], NORM_EPS)
        proj = jnp.einsum('bsd,de->bse', u, w_in[layer])
        hy_in = proj[..., :o_hg]
        hy_gate = proj[..., o_hg:o_q]
        q = proj[..., o_q:o_k]
        k = proj[..., o_k:o_v]
        v = proj[..., o_v:o_ag]
        at_gate = proj[..., o_ag:]
        kf = hyena_filter_spectra(S, filt_w1[layer], filt_b1[layer], filt_w2[layer], filt_b2[layer],
                                  filt_w3[layer], filt_b3[layer], filt_freq[layer], filt_w4[layer])
        y_h = hyena_branch(hy_in, conv_w[layer], conv_b[layer], kf, filt_bias[layer]) * jax.nn.silu(hy_gate)
        y_a = diff_attn_branch(q, k, v, cos, sin, lam_q1[layer], lam_k1[layer], lam_q2[layer],
                               lam_k2[layer], subln_g[layer], lam_init) * jax.nn.silu(at_gate)
        y = jnp.concatenate([y_h, y_a], axis=-1)
        h = h + jnp.einsum('bsm,md->bsd', y, w_out[layer])
    return rmsnorm(h, final_g, NORM_EPS)
```

```cpp
#include <hip/hip_runtime.h>
#include <hip/hip_cooperative_groups.h>
#include <cstdio>
namespace cg = cooperative_groups;

#ifndef SINGLE_LAUNCH
#define SINGLE_LAUNCH 1
#endif

typedef unsigned short u16;
using bf16x8 = __attribute__((ext_vector_type(8))) short;
using f32x16 = __attribute__((ext_vector_type(16))) float;
using u32x4 = __attribute__((ext_vector_type(4))) unsigned;
using f32x4 = __attribute__((ext_vector_type(4))) float;
typedef __bf16 bf2_t __attribute__((ext_vector_type(2)));
typedef float f2_t __attribute__((ext_vector_type(2)));
#define DI __device__ __forceinline__
DI int fresh_tid() { int t = threadIdx.x; asm volatile("" : "+v"(t)); return t; }
#define MFMA(a, b, c) __builtin_amdgcn_mfma_f32_32x32x16_bf16((a), (b), (c), 0, 0, 0)

constexpr int SEQ = 8192;
constexpr int NTOK = 16384;
constexpr int NT = 512;
constexpr int HYP = NTOK + 64;
constexpr int VTP = SEQ + 64;
constexpr int LDS_BYTES = 149504;

struct P {
  const float *x, *norm_g, *w_in, *conv_w, *conv_b, *fw1, *fb1, *fw2, *fb2, *fw3, *fb3, *ffreq, *fw4, *fbias,
      *lq1, *lk1, *lq2, *lk2, *subg, *w_out, *final_g;
  float* out;
  u16 *WinT, *WoutT, *hb, *hyT, *Qb, *Kb, *VT, *AG, *Ya, *YhT, *Tb;
  float *ssq, *npart;
  float2* rope;
  unsigned* kmax;
  unsigned* bar;
};

DI P load_args() {
#if defined(__HIP_DEVICE_COMPILE__)
  typedef const __attribute__((address_space(4))) P* kargp_t;
  kargp_t pp = (kargp_t)__builtin_amdgcn_kernarg_segment_ptr();
  asm volatile("" : "+s"(pp));
  return *pp;
#else
  return P{};
#endif
}

DI unsigned pack2(float a, float b) {
  f2_t v = {a, b};
  bf2_t r = __builtin_convertvector(v, bf2_t);
  return __builtin_bit_cast(unsigned, r);
}
DI u16 f2bf(float a) { return (u16)(pack2(a, 0.f) & 0xffffu); }
DI float bf2f(unsigned v) { return __uint_as_float(v << 16); }
DI float bflo(unsigned v) { return __uint_as_float(v << 16); }
DI float bfhi(unsigned v) { return __uint_as_float(v & 0xffff0000u); }
DI int crow(int reg, int g) { return (reg & 3) + 8 * (reg >> 2) + 4 * g; }
DI float siluf(float x) { return x * __builtin_amdgcn_rcpf(1.f + __expf(-x)); }
DI f32x16 zero16() { f32x16 z; for (int i = 0; i < 16; ++i) z[i] = 0.f; return z; }

DI void phase_prep(char* smem) {
  const P p = load_args();
  const int tid = threadIdx.x;
  {
    u16* T = (u16*)smem;
    const int kr = tid >> 4, nq = tid & 15;
    const int nr = tid >> 3, kq = tid & 7;
    for (int it = blockIdx.x; it < 2560; it += gridDim.x) {
      const int l = it / 1280, r = it % 1280;
      const float* W; u16* WT; int N; const float* gg; int tile;
      if (r < 1024) { W = p.w_in + (size_t)l * 1024 * 4096; WT = p.WinT + (size_t)l * 4096 * 1024; N = 4096; gg = p.norm_g + l * 1024; tile = r; }
      else { W = p.w_out + (size_t)l * 1024 * 1024; WT = p.WoutT + (size_t)l * 1024 * 1024; N = 1024; gg = nullptr; tile = r - 1024; }
      const int ntn = N / 64;
      const int tn = tile % ntn, tk = tile / ntn;
      const int n0 = tn * 64, k0 = tk * 64;
      const f32x4 va = *(const f32x4*)(W + (size_t)(k0 + kr) * N + n0 + 4 * nq);
      const f32x4 vb = *(const f32x4*)(W + (size_t)(k0 + kr + 32) * N + n0 + 4 * nq);
      const float ga = gg ? gg[k0 + kr] : 1.0f, gb = gg ? gg[k0 + kr + 32] : 1.0f;
      __syncthreads();
#pragma unroll
      for (int j = 0; j < 4; ++j) {
        T[kr * 66 + 4 * nq + j] = f2bf(va[j] * ga);
        T[(kr + 32) * 66 + 4 * nq + j] = f2bf(vb[j] * gb);
      }
      __syncthreads();
      u32x4 o;
#pragma unroll
      for (int j2 = 0; j2 < 4; ++j2)
        o[j2] = (unsigned)T[(8 * kq + 2 * j2) * 66 + nr] | ((unsigned)T[(8 * kq + 2 * j2 + 1) * 66 + nr] << 16);
      *(u32x4*)(WT + (size_t)(n0 + nr) * 1024 + k0 + 8 * kq) = o;
    }
    __syncthreads();
  }
  if (blockIdx.x == 0 && tid < 16) p.kmax[tid] = 0u;
  for (int i = blockIdx.x * NT + tid; i < SEQ * 32; i += gridDim.x * NT) {
    const int pos = i >> 5, j = i & 31;
    const float invf = exp2f(-(float)j * (13.287712379549449f / 32.0f));
    float sn, cs;
    sincosf((float)pos * invf, &sn, &cs);
    p.rope[i] = make_float2(cs, sn);
  }
  {
    const int lane = tid & 63, wave = tid >> 6;
    for (int rp = blockIdx.x * 8 + wave; rp < NTOK / 2; rp += gridDim.x * 8) {
      f32x4 v[2][4];
#pragma unroll
      for (int h2 = 0; h2 < 2; ++h2)
#pragma unroll
        for (int i = 0; i < 4; ++i) v[h2][i] = ((const f32x4*)(p.x + (size_t)(2 * rp + h2) * 1024))[lane + 64 * i];
#pragma unroll
      for (int h2 = 0; h2 < 2; ++h2) {
        const int row = 2 * rp + h2;
        float s = 0.f;
#pragma unroll
        for (int i = 0; i < 4; ++i) {
          const f32x4 w = v[h2][i];
          s += w[0] * w[0] + w[1] * w[1] + w[2] * w[2] + w[3] * w[3];
          uint2 o; o.x = pack2(w[0], w[1]); o.y = pack2(w[2], w[3]);
          *(uint2*)(p.hb + (size_t)row * 1024 + (lane + 64 * i) * 4) = o;
        }
#pragma unroll
        for (int m = 32; m >= 1; m >>= 1) s += __shfl_xor(s, m);
        if (lane < 8) p.ssq[row * 8 + lane] = (lane == 0) ? s : 0.f;
      }
    }
  }
}

DI void filter_tile(const P& p, int l, int tile, char* smem) {
  float* z = (float*)smem;
  float* h1 = z + 32 * 36;
  float* h2 = h1 + 32 * 68;
  u16* h3 = (u16*)(h2 + 32 * 68);
  const int tid = fresh_tid();
  const int m0 = tile * 32;
  for (int idx = tid; idx < 32 * 33; idx += NT) {
    const int pp = idx / 33, e = idx % 33;
    const int m = m0 + pp;
    float val;
    if (e == 0) val = (float)m / 8191.0f;
    else {
      const int j = (e - 1) & 15;
      const float fbj = 1e-4f + (float)j * ((15.0f - 1e-4f) / 15.0f);
      const float wpos = (6.283185307179586f * (float)m) / 8192.0f;
      const float ph = wpos * fbj;
      val = (e <= 16) ? cosf(ph) : -sinf(ph);
    }
    z[pp * 36 + e] = val;
  }
  const int r = tid & 63, pq = tid >> 6;
  const float fr = p.ffreq[l * 64 + r];
  float* Ws = (float*)(h3 + 32 * 72);
  f32x4 wq1[2], wq2[2], wq3[2];
  {
    const f32x4* w1 = (const f32x4*)(p.fw1 + l * 33 * 64);
    const f32x4* w2 = (const f32x4*)(p.fw2 + l * 64 * 64);
    const f32x4* w3 = (const f32x4*)(p.fw3 + l * 64 * 64);
#pragma unroll
    for (int i = 0; i < 2; ++i) { const int q = tid + NT * i; wq1[i] = w1[(q < 528) ? q : 0]; }
#pragma unroll
    for (int i = 0; i < 2; ++i) { wq2[i] = w2[tid + NT * i]; wq3[i] = w3[tid + NT * i]; }
  }
  const float b1v = p.fb1[l * 64 + r], b2v = p.fb2[l * 64 + r], b3v = p.fb3[l * 64 + r];
#pragma unroll
  for (int i = 0; i < 2; ++i) { const int q = tid + NT * i; if (q < 528) ((f32x4*)Ws)[q] = wq1[i]; }
  __syncthreads();
  {
    float s[4];
#pragma unroll
    for (int i = 0; i < 4; ++i) s[i] = b1v;
#pragma unroll 3
    for (int e = 0; e < 33; ++e) {
      const float wv = Ws[e * 64 + r];
#pragma unroll
      for (int i = 0; i < 4; ++i) s[i] += z[(pq + 8 * i) * 36 + e] * wv;
    }
#pragma unroll
    for (int i = 0; i < 4; ++i) h1[(pq + 8 * i) * 68 + r] = sinf(fr * s[i]);
  }
  __syncthreads();
#pragma unroll
  for (int i = 0; i < 2; ++i) ((f32x4*)Ws)[tid + NT * i] = wq2[i];
  __syncthreads();
  {
    float s[4];
#pragma unroll
    for (int i = 0; i < 4; ++i) s[i] = b2v;
#pragma unroll 4
    for (int e = 0; e < 64; ++e) {
      const float wv = Ws[e * 64 + r];
#pragma unroll
      for (int i = 0; i < 4; ++i) s[i] += h1[(pq + 8 * i) * 68 + e] * wv;
    }
#pragma unroll
    for (int i = 0; i < 4; ++i) h2[(pq + 8 * i) * 68 + r] = sinf(fr * s[i]);
  }
  __syncthreads();
#pragma unroll
  for (int i = 0; i < 2; ++i) ((f32x4*)Ws)[tid + NT * i] = wq3[i];
  __syncthreads();
  {
    float s[4];
#pragma unroll
    for (int i = 0; i < 4; ++i) s[i] = b3v;
#pragma unroll 4
    for (int e = 0; e < 64; ++e) {
      const float wv = Ws[e * 64 + r];
#pragma unroll
      for (int i = 0; i < 4; ++i) s[i] += h2[(pq + 8 * i) * 68 + e] * wv;
    }
#pragma unroll
    for (int i = 0; i < 4; ++i) h3[(pq + 8 * i) * 72 + r] = f2bf(sinf(fr * s[i]));
  }
  __syncthreads();
  const int lane = tid & 63, wave = tid >> 6, li = lane & 31, g = lane >> 5;
  bf16x8 af[4];
#pragma unroll
  for (int ks = 0; ks < 4; ++ks) af[ks] = *(const bf16x8*)(h3 + li * 72 + 16 * ks + 8 * g);
  const float* w4 = p.fw4 + (size_t)l * 64 * 2048;
  const float min_decay = -3.0701134573253944f, max_decay = -15.350567286626973f;
  for (int nb = 0; nb < 8; nb += 2) {
    u32x4 bw[2][4];
#pragma unroll
    for (int u = 0; u < 2; ++u) {
      const int col = wave * 256 + (nb + u) * 32 + li;
#pragma unroll
      for (int ks = 0; ks < 4; ++ks) {
        const float* wp = w4 + (size_t)(16 * ks + 8 * g) * 2048 + col;
        const float a0 = wp[0], a1 = wp[2048], a2 = wp[2 * 2048], a3 = wp[3 * 2048];
        const float a4 = wp[4 * 2048], a5 = wp[5 * 2048], a6 = wp[6 * 2048], a7 = wp[7 * 2048];
        u32x4 t; t[0] = pack2(a0, a1); t[1] = pack2(a2, a3); t[2] = pack2(a4, a5); t[3] = pack2(a6, a7);
        bw[u][ks] = t;
      }
    }
#pragma unroll
    for (int u = 0; u < 2; ++u) {
      const int col = wave * 256 + (nb + u) * 32 + li;
      f32x16 acc = zero16();
#pragma unroll
      for (int ks = 0; ks < 4; ++ks) acc = MFMA(af[ks], __builtin_bit_cast(bf16x8, bw[u][ks]), acc);
      const int j = col >> 9, c = col & 511;
      const int order = j & 1;
      const bool fwd = j < 2;
      const float delta = fabsf(min_decay + (float)c * ((max_decay - min_decay) / 511.0f));
      u16* tb = p.Tb + (size_t)(order * 512 + c) * 16384;
      float asum = 0.f;
#pragma unroll
      for (int reg = 0; reg < 16; ++reg) {
        const int m = m0 + crow(reg, g);
        const float t = (float)m / 8191.0f;
        const float v = acc[reg] * __expf(-t * delta);
        if (fwd) { tb[8192 - m] = f2bf(v); asum += fabsf(v); }
        else if (m >= 1) { tb[8192 + m] = f2bf(v); asum += fabsf(v); }
      }
      if (fwd && tile == 0 && g == 0) tb[0] = 0;
      asum += __shfl_xor(asum, 32);
      if (g == 0) p.npart[(size_t)tile * 2048 + col] = asum;
    }
  }
}

template <bool AT>
DI void gemm_main(f32x16 (&acc)[2][4], const u16* __restrict__ R, int ldr, const u16* __restrict__ Cm, int ldc,
                  const u16* __restrict__ RT, int ldrt, int K, char* smem, int tid) {
  constexpr int STG = 2 * 256 * 72;
  u16* S0 = (u16*)smem;
  const int lane = tid & 63, wave = tid >> 6, wr = wave >> 1, wc = wave & 1;
  const int li = lane & 31, g = lane >> 5;
  u32x4 rr[4], cr[4];
#pragma unroll
  for (int a = 0; a < 2; ++a)
#pragma unroll
    for (int b = 0; b < 4; ++b) acc[a][b] = zero16();
  const int nk = K / 64;
#pragma unroll
  for (int i = 0; i < 4; ++i) {
    const int cid = tid + NT * i;
    const int row = cid >> 3, kc = cid & 7;
    if (AT) {
      const int kr = cid >> 5, tc = cid & 31;
      rr[i] = *(const u32x4*)(RT + (size_t)kr * ldrt + tc * 8);
    } else {
      rr[i] = *(const u32x4*)(R + (size_t)row * ldr + kc * 8);
    }
    cr[i] = *(const u32x4*)(Cm + (size_t)row * ldc + kc * 8);
  }
  for (int kt = -1; kt < nk; ++kt) {
    if (kt + 1 < nk) {
      const int ks1 = kt + 1;
      u16* Rs = S0 + (ks1 & 1) * STG;
      u16* Cs = Rs + 256 * 72;
#pragma unroll
      for (int i = 0; i < 4; ++i) {
        const int cid = tid + NT * i;
        const int row = cid >> 3, kc = cid & 7;
        if (AT && ks1 < 8) {
          const int kr = cid >> 5, tc = cid & 31;
          *(u32x4*)(Rs + kr * 264 + tc * 8) = rr[i];
        } else {
          *(u32x4*)(Rs + row * 72 + kc * 8) = rr[i];
        }
        *(u32x4*)(Cs + row * 72 + kc * 8) = cr[i];
      }
    }
    if (kt + 2 < nk) {
      const int kn = kt + 2;
#pragma unroll
      for (int i = 0; i < 4; ++i) {
        const int cid = tid + NT * i;
        const int row = cid >> 3, kc = cid & 7;
        if (AT && kn < 8) {
          const int kr = cid >> 5, tc = cid & 31;
          rr[i] = *(const u32x4*)(RT + (size_t)(kn * 64 + kr) * ldrt + tc * 8);
        } else {
          rr[i] = *(const u32x4*)(R + (size_t)row * ldr + kn * 64 + kc * 8);
        }
        cr[i] = *(const u32x4*)(Cm + (size_t)row * ldc + kn * 64 + kc * 8);
      }
    }
    __builtin_amdgcn_sched_barrier(0);
    if (kt >= 0) {
      const u16* Rs = S0 + (kt & 1) * STG;
      const u16* Cs = Rs + 256 * 72;
      const u16* RTs = Rs;
#pragma unroll
      for (int ks = 0; ks < 4; ++ks) {
        bf16x8 rf[2];
#pragma unroll
        for (int rb = 0; rb < 2; ++rb) {
          if (AT && kt < 8) {
            const u16* src = RTs + (16 * ks + 8 * g) * 264 + 64 * wr + 32 * rb + li;
            bf16x8 t;
#pragma unroll
            for (int j = 0; j < 8; ++j) t[j] = (short)src[j * 264];
            rf[rb] = t;
          } else {
            rf[rb] = *(const bf16x8*)(Rs + (64 * wr + 32 * rb + li) * 72 + 16 * ks + 8 * g);
          }
        }
#pragma unroll
        for (int cb = 0; cb < 4; ++cb) {
          const bf16x8 cfv = *(const bf16x8*)(Cs + (128 * wc + 32 * cb + li) * 72 + 16 * ks + 8 * g);
#pragma unroll
          for (int rb = 0; rb < 2; ++rb) acc[rb][cb] = MFMA(rf[rb], cfv, acc[rb][cb]);
        }
      }
    }
    __syncthreads();
  }
}

template <bool TR>
DI void gemm_in_tile(const P& p, int l, int id, char* smem) {
  const int tid = fresh_tid(), lane = tid & 63, wave = tid >> 6, wr = wave >> 1, wc = wave & 1;
  const int li = lane & 31, g = lane >> 5;
  float* rs_s = (float*)(smem + 147456);
  const int kk = id >> 8, bx = id & 255, xcd = bx & 7, s = bx >> 3;
  const int mt = xcd * 8 + (s & 7), nt = 4 * kk + (s >> 3);
  const int m0 = mt * 256, n0 = nt * 256;
  constexpr bool tr = TR;
  if (tid < 256) {
    const float4* q = (const float4*)(p.ssq + (size_t)(m0 + tid) * 8);
    const float4 a = q[0], b = q[1];
    rs_s[tid] = rsqrtf((a.x + a.y + a.z + a.w + b.x + b.y + b.z + b.w) * (1.0f / 1024.0f) + 1e-6f);
  }
  const u16* A = p.hb + (size_t)m0 * 1024;
  const u16* B = p.WinT + (size_t)l * 4096 * 1024 + (size_t)n0 * 1024;
  f32x16 acc[2][4];
  if (TR) gemm_main<false>(acc, B, 1024, A, 1024, nullptr, 0, 1024, smem, tid);
  else gemm_main<false>(acc, A, 1024, B, 1024, nullptr, 0, 1024, smem, tid);
  if (tr) {
    const bool hy = nt < 8;
#pragma unroll
    for (int cb = 0; cb < 4; ++cb) {
      asm volatile("" ::: "memory");
      const int tl = 128 * wc + 32 * cb + li;
      const int tok = m0 + tl;
      const float rs = rs_s[tl];
      u16* dst = hy ? (p.hyT + (size_t)(n0 + 64 * wr) * HYP + tok)
                    : (p.VT + (size_t)((tok >> 13) * 512 + (n0 - 3072) + 64 * wr) * VTP + (tok & 8191));
      const size_t cstride = hy ? (size_t)HYP : (size_t)VTP;
#pragma unroll
      for (int rb = 0; rb < 2; ++rb) {
#pragma unroll
        for (int reg = 0; reg < 16; ++reg) {
          const int cl = 32 * rb + crow(reg, g);
          dst[(size_t)cl * cstride] = f2bf(acc[rb][cb][reg] * rs);
        }
      }
    }
  } else if (nt < 12) {
    const bool isq = nt < 10;
    const int h = (nt & 1) * 2 + wc;
    u16* dst = isq ? p.Qb : p.Kb;
    const float qs = isq ? (0.125f * 1.4426950408889634f) : 1.0f;
    float kl0 = 0.f, kl1 = 0.f;
#pragma unroll
    for (int rb = 0; rb < 2; ++rb) {
#pragma unroll
      for (int reg = 0; reg < 16; ++reg) {
        if ((reg & 3) == 0) asm volatile("" ::: "memory");
        const int rl = 64 * wr + 32 * rb + crow(reg, g);
        const int tok = m0 + rl;
        const float rs = rs_s[rl] * qs;
        const int pos = tok & 8191, b = tok >> 13;
        const float2 cs = p.rope[pos * 32 + li];
#pragma unroll
        for (int c = 0; c < 2; ++c) {
          const float x1 = acc[rb][2 * c][reg] * rs, x2 = acc[rb][2 * c + 1][reg] * rs;
          const float o1 = x1 * cs.x - x2 * cs.y, o2 = x2 * cs.x + x1 * cs.y;
          const size_t base = ((size_t)(((b * 4 + h) * 2 + c) * SEQ + pos)) * 64;
          dst[base + li] = f2bf(o1);
          dst[base + 32 + li] = f2bf(o2);
          if (c == 0) kl0 = fmaxf(kl0, o1 * o1 + o2 * o2); else kl1 = fmaxf(kl1, o1 * o1 + o2 * o2);
        }
      }
    }
    if (!isq) {
#pragma unroll
      for (int m = 16; m >= 1; m >>= 1) { kl0 += __shfl_xor(kl0, m); kl1 += __shfl_xor(kl1, m); }
      kl0 = fmaxf(kl0, __shfl_xor(kl0, 32)) * 1.02f;
      kl1 = fmaxf(kl1, __shfl_xor(kl1, 32)) * 1.02f;
      if (lane == 0) {
        atomicMax(p.kmax + (m0 >> 13) * 8 + h * 2 + 0, __float_as_uint(kl0));
        atomicMax(p.kmax + (m0 >> 13) * 8 + h * 2 + 1, __float_as_uint(kl1));
      }
    }
  } else {
#pragma unroll
    for (int rb = 0; rb < 2; ++rb) {
#pragma unroll
      for (int reg = 0; reg < 16; ++reg) {
        if ((reg & 3) == 0) asm volatile("" ::: "memory");
        const int rl = 64 * wr + 32 * rb + crow(reg, g);
        const int tok = m0 + rl;
        const float rs = rs_s[rl];
#pragma unroll
        for (int cb = 0; cb < 4; ++cb) {
          const int col = n0 - 3584 + 128 * wc + 32 * cb + li;
          p.AG[(size_t)tok * 512 + col] = f2bf(siluf(acc[rb][cb][reg] * rs));
        }
      }
    }
  }
}

DI void phase_in(int l, char* smem, int lo = 0, int hi = 1024 + 256) {
  const P p = load_args();
  for (int it = lo + blockIdx.x; it < hi; it += gridDim.x) {
    __syncthreads();
    if (it < 1024) {
      const int nt = 4 * (it >> 8) + ((it & 255) >> 6);
      if ((nt < 8) || (nt == 12) || (nt == 13)) gemm_in_tile<true>(p, l, it, smem);
      else gemm_in_tile<false>(p, l, it, smem);
    } else filter_tile(p, l, it - 1024, smem);
  }
}

DI void gemm_out_tile(const P& p, int l, int id, char* smem) {
  const int bx = id & 255, xcd = bx & 7, s = bx >> 3;
  const int mt = xcd * 8 + (s & 7), nt = s >> 3;
  const int m0 = mt * 256, n0 = nt * 256;
  const int tid = fresh_tid(), lane = tid & 63, wave = tid >> 6, wr = wave >> 1, wc = wave & 1;
  const int li = lane & 31, g = lane >> 5;
  f32x16 acc[2][4];
  const u16* R = p.Ya + (size_t)m0 * 512 - 512;
  const u16* Cm = p.WoutT + (size_t)l * 1024 * 1024 + (size_t)n0 * 1024;
  const u16* RT = p.YhT + m0;
  gemm_main<true>(acc, R, 512, Cm, 1024, RT, HYP, 1024, smem, tid);
  __syncthreads();
  float* red = (float*)smem;
  const bool odd = (li & 1) != 0;
#pragma unroll
  for (int rb = 0; rb < 2; ++rb) {
#pragma unroll
    for (int reg = 0; reg < 16; reg += 2) {
      const int rl = 64 * wr + 32 * rb + crow(reg + (odd ? 1 : 0), g);
      const int tok = m0 + rl;
      float sacc = 0.f;
#pragma unroll
      for (int cb = 0; cb < 4; ++cb) {
        const float a = acc[rb][cb][reg], b = acc[rb][cb][reg + 1];
        const float x = odd ? a : b;
        const float y = __int_as_float(__builtin_amdgcn_mov_dpp(__float_as_int(x), 0xB1, 0xF, 0xF, true));
        const float lo = odd ? y : a, hi = odd ? b : y;
        const size_t idx = (size_t)tok * 1024 + n0 + 128 * wc + 32 * cb + (li & ~1);
        const unsigned hv = *(const unsigned*)(p.hb + idx);
        const float h0 = bflo(hv) + lo, h1 = bfhi(hv) + hi;
        *(unsigned*)(p.hb + idx) = pack2(h0, h1);
        sacc += h0 * h0 + h1 * h1;
      }
#pragma unroll
      for (int m = 16; m >= 2; m >>= 1) sacc += __shfl_xor(sacc, m);
      if (li < 2) red[wc * 256 + rl] = sacc;
    }
  }
  __syncthreads();
  if (tid < 256) {
    const float v = red[tid] + red[256 + tid];
    p.ssq[(size_t)(m0 + tid) * 8 + 2 * nt] = v;
    p.ssq[(size_t)(m0 + tid) * 8 + 2 * nt + 1] = 0.f;
  }
}

DI void phase_out(int l, char* smem) {
  const P p = load_args();
  for (int it = blockIdx.x; it < 256; it += gridDim.x) {
    __syncthreads();
    gemm_out_tile(p, l, it, smem);
  }
}

DI void attn_item(const P& p, int l, int item, char* smem) {
  u16* Ks = (u16*)smem;
  const int tid = fresh_tid(), lane = tid & 63, wave = tid >> 6;
  const int li = lane & 31, g = lane >> 5;
  const int qg = wave & 3, c = wave >> 2;
  const int bh = item & 7, qb = (item >> 8) * 32 + ((item & 255) >> 3);
  const int b = bh >> 2, h = bh & 3;
  const float lam_init = (l == 0) ? 0.2f : 0.35550906759096926f;
  float lam;
  {
    float s1 = p.lq1[l * 64 + lane] * p.lk1[l * 64 + lane];
    float s2 = p.lq2[l * 64 + lane] * p.lk2[l * 64 + lane];
#pragma unroll
    for (int m = 32; m >= 1; m >>= 1) { s1 += __shfl_xor(s1, m); s2 += __shfl_xor(s2, m); }
    lam = __expf(s1) - __expf(s2) + lam_init;
  }
  const int tq = qb * 128 + qg * 32 + li;
  bf16x8 qf[4];
  float negm;
  {
    float q2 = 0.f;
#pragma unroll
    for (int ks = 0; ks < 4; ++ks) {
      qf[ks] = *(const bf16x8*)(p.Qb + ((size_t)((bh * 2 + c) * SEQ + tq)) * 64 + 16 * ks + 8 * g);
#pragma unroll
      for (int j = 0; j < 8; ++j) { const float v = bf2f((unsigned)(u16)qf[ks][j]); q2 += v * v; }
    }
    q2 += __shfl_xor(q2, 32);
    const float k2 = __uint_as_float(p.kmax[bh * 2 + c]);
    negm = -(sqrtf(q2 * k2) * 1.01f + 1e-3f);
  }
  f32x16 O[4];
#pragma unroll
  for (int eb = 0; eb < 4; ++eb) O[eb] = zero16();
  float ls = 0.f;
  u32x4 kreg[2], vreg[2];
  const u16* kbase = p.Kb + (size_t)(bh * 2) * SEQ * 64;
  const u16* vbase = p.VT + (size_t)(bh * 128) * VTP;
#pragma unroll
  for (int i = 0; i < 2; ++i) kreg[i] = *(const u32x4*)(kbase + ((size_t)i * SEQ) * 64 + tid * 8);
#pragma unroll
  for (int i = 0; i < 2; ++i) {
    const int cid = tid + NT * i;
    const int e = cid >> 3, kc = cid & 7;
    vreg[i] = *(const u32x4*)(vbase + (size_t)e * VTP + kc * 8);
  }
  for (int kt = -1; kt < 128; ++kt) {
    if (kt + 1 < 128) {
      u16* Kd = Ks + ((kt + 1) & 1) * (256 * 72);
      u16* Vd = Kd + 2 * 64 * 72;
#pragma unroll
      for (int i = 0; i < 2; ++i) {
        const int row = tid >> 3, kc = tid & 7;
        *(u32x4*)(Kd + (i * 64 + row) * 72 + kc * 8) = kreg[i];
      }
#pragma unroll
      for (int i = 0; i < 2; ++i) {
        const int cid = tid + NT * i;
        const int e = cid >> 3, kc = cid & 7;
        uint2 w0; w0.x = vreg[i][0]; w0.y = vreg[i][1];
        uint2 w1; w1.x = vreg[i][2]; w1.y = vreg[i][3];
        u16* vd = Vd + e * 72 + (kc >> 1) * 16 + (kc & 1) * 4;
        *(uint2*)vd = w0;
        *(uint2*)(vd + 8) = w1;
      }
    }
    if (kt + 2 < 128) {
      const int kn = kt + 2;
#pragma unroll
      for (int i = 0; i < 2; ++i) kreg[i] = *(const u32x4*)(kbase + ((size_t)i * SEQ + kn * 64) * 64 + tid * 8);
#pragma unroll
      for (int i = 0; i < 2; ++i) {
        const int cid = tid + NT * i;
        const int e = cid >> 3, kc = cid & 7;
        vreg[i] = *(const u32x4*)(vbase + (size_t)e * VTP + kn * 64 + kc * 8);
      }
    }
    __builtin_amdgcn_sched_barrier(0);
    if (kt >= 0) {
      const u16* Kc = Ks + (kt & 1) * (256 * 72);
      const u16* Vc = Kc + 2 * 64 * 72;
      bf16x8 kf[8];
#pragma unroll
      for (int i = 0; i < 8; ++i)
        kf[i] = *(const bf16x8*)(Kc + (c * 64 + 32 * (i & 1) + li) * 72 + 16 * (i >> 1) + 8 * g);
      u32x4 vf[16];
#pragma unroll
      for (int i = 0; i < 16; ++i) {
        const int eb = i & 3, s = (i >> 2) & 1, kb = i >> 3;
        vf[i] = *(const u32x4*)(Vc + (32 * eb + li) * 72 + 32 * kb + 16 * s + 8 * g);
      }
      f32x16 S[2];
#pragma unroll
      for (int kb = 0; kb < 2; ++kb)
#pragma unroll
        for (int r = 0; r < 16; ++r) S[kb][r] = negm;
#pragma unroll
      for (int i = 0; i < 8; ++i) S[i & 1] = MFMA(kf[i], qf[i >> 1], S[i & 1]);
      u32x4 pk[4];
      float sum = 0.f;
#pragma unroll
      for (int ch = 0; ch < 4; ++ch) {
        const int kb = ch >> 1, s = ch & 1;
#pragma unroll
        for (int j2 = 0; j2 < 4; ++j2) {
          const float p0 = __builtin_amdgcn_exp2f(S[kb][8 * s + 2 * j2]);
          const float p1 = __builtin_amdgcn_exp2f(S[kb][8 * s + 2 * j2 + 1]);
          sum += p0 + p1;
          pk[ch][j2] = pack2(p0, p1);
        }
      }
      ls += sum;
#pragma unroll
      for (int i = 0; i < 16; ++i) {
        const int eb = i & 3, ch = i >> 2;
        O[eb] = MFMA(__builtin_bit_cast(bf16x8, vf[i]), __builtin_bit_cast(bf16x8, pk[ch]), O[eb]);
      }
    }
    __syncthreads();
  }
  const float lt = ls + __shfl_xor(ls, 32);
  const float inv = (c == 0) ? (1.0f / lt) : (lam / lt);
  float* exch = (float*)smem + qg * (64 * 64);
  if (c == 1) {
#pragma unroll
    for (int eb = 0; eb < 4; ++eb)
#pragma unroll
      for (int r = 0; r < 16; ++r) exch[(eb * 16 + r) * 64 + lane] = O[eb][r] * inv;
  }
  __syncthreads();
  if (c == 0) {
    float ss = 0.f;
#pragma unroll
    for (int eb = 0; eb < 4; ++eb)
#pragma unroll
      for (int r = 0; r < 16; ++r) {
        const float o = O[eb][r] * inv - exch[(eb * 16 + r) * 64 + lane];
        O[eb][r] = o;
        ss += o * o;
      }
    ss += __shfl_xor(ss, 32);
    const float rn = rsqrtf(ss * (1.0f / 128.0f) + 1e-5f) * (1.0f - lam_init);
    const size_t tok = (size_t)b * SEQ + tq;
#pragma unroll
    for (int eb = 0; eb < 4; ++eb)
#pragma unroll
      for (int rq = 0; rq < 4; ++rq) {
        const int e = 32 * eb + 8 * rq + 4 * g;
        const uint2 gt = *(const uint2*)(p.AG + tok * 512 + h * 128 + e);
        const float4 sg = *(const float4*)(p.subg + l * 128 + e);
        const float o0 = O[eb][4 * rq + 0] * rn * sg.x * bflo(gt.x);
        const float o1 = O[eb][4 * rq + 1] * rn * sg.y * bfhi(gt.x);
        const float o2 = O[eb][4 * rq + 2] * rn * sg.z * bflo(gt.y);
        const float o3 = O[eb][4 * rq + 3] * rn * sg.w * bfhi(gt.y);
        uint2 ov; ov.x = pack2(o0, o1); ov.y = pack2(o2, o3);
        *(uint2*)(p.Ya + tok * 512 + h * 128 + e) = ov;
      }
  }
}

DI void sconv4(const u16* row, int t4, float w0, float w1, float w2, float bias, float (&o)[4]) {
  const uint2 v = *(const uint2*)(row + t4);
  const float x0 = bflo(v.x), x1 = bfhi(v.x), x2 = bflo(v.y), x3 = bfhi(v.y);
  const float xm = (t4 > 0) ? bf2f(row[t4 - 1]) : 0.f;
  const float xp = (t4 + 4 < SEQ) ? bf2f(row[t4 + 4]) : 0.f;
  o[0] = w0 * xm + w1 * x0 + w2 * x1 + bias;
  o[1] = w0 * x0 + w1 * x1 + w2 * x2 + bias;
  o[2] = w0 * x1 + w1 * x2 + w2 * x3 + bias;
  o[3] = w0 * x2 + w1 * x3 + w2 * xp + bias;
}

DI void hy_load_table(const u16* __restrict__ tbg, u16* TbE, u16* TbO, int tid) {
#pragma unroll
  for (int i = 0; i < 4; ++i) {
    const int q = tid + NT * i;
    const uint4 v = *(const uint4*)(tbg + 8 * q);
    const unsigned nxt = (q < 2047) ? (unsigned)tbg[8 * q + 8] : 0u;
    *(uint4*)(TbE + 8 * q) = v;
    uint4 o;
    o.x = (v.x >> 16) | (v.y << 16);
    o.y = (v.y >> 16) | (v.z << 16);
    o.z = (v.z >> 16) | (v.w << 16);
    o.w = (v.w >> 16) | (nxt << 16);
    *(uint4*)(TbO + 8 * q) = o;
  }
}

DI u32x4 hy_afrag(const u16* abase, int f) {
  const unsigned* ap = (const unsigned*)(abase - 16 * f);
  u32x4 r; r[0] = ap[0]; r[1] = ap[1]; r[2] = ap[2]; r[3] = ap[3];
  return r;
}

DI void hy_bfrag(bf16x8 (&bf)[8], const u16* U, const u16* Zrow, int a0, int li, int g, int d) {
  const int ap = a0 + (li & 15) - d;
  const bool valid = (unsigned)ap < 64u;
  const u16* bb = valid ? (U + ((li >> 4) * 64 + ap) * 136 + 8 * g) : (Zrow + 8 * g);
#pragma unroll
  for (int kc = 0; kc < 8; ++kc) bf[kc] = *(const bf16x8*)(bb + 16 * kc);
}

DI void hy_conv(f32x16 (&acc)[4], const u16* abase, const u16* U, const u16* Zrow, int a0, int li, int g) {
#pragma unroll
  for (int i = 0; i < 4; ++i) acc[i] = zero16();
  u32x4 W[14];
  bf16x8 bf[8];
  int d = a0 - 63;
#pragma unroll
  for (int x = 0; x < 14; ++x) W[x] = hy_afrag(abase, 8 * d + x - 7);
  for (; d <= a0 + 15; ++d) {
    hy_bfrag(bf, U, Zrow, a0, li, g, d);
    u32x4 Wn[8];
    const int dn = (d < a0 + 15) ? d + 1 : d;
#pragma unroll
    for (int x = 0; x < 8; ++x) Wn[x] = hy_afrag(abase, 8 * dn + x - 1);
#pragma unroll
    for (int kc = 0; kc < 8; ++kc)
#pragma unroll
      for (int I = 0; I < 4; ++I) acc[I] = MFMA(__builtin_bit_cast(bf16x8, W[2 * I - kc + 7]), bf[kc], acc[I]);
#pragma unroll
    for (int x = 0; x < 6; ++x) W[x] = W[x + 8];
#pragma unroll
    for (int x = 0; x < 8; ++x) W[x + 6] = Wn[x];
  }
}

DI void hyena_item(const P& p, int l, int c, char* smem) {
  u16* TbE = (u16*)smem;
  u16* TbO = TbE + 16384 + 32;
  u16* U = TbO + 16384 + 32;
  u16* Zrow = U + 2 * 64 * 136;
  float* misc = (float*)(Zrow + 136);
  const int tid = fresh_tid(), lane = tid & 63, wave = tid >> 6;
  const int li = lane & 31, g = lane >> 5;
  const int a0 = 16 * (wave & 3);
  const bool cwv = wave < 4;
  const u16* tbg = p.Tb + (size_t)c * 16384;
  {
    const float* np = p.npart + (size_t)(tid & 255) * 2048;
    float v0 = (tid < 256) ? np[c] + np[1024 + c] : 0.f;
    float v1 = (tid < 256) ? np[512 + c] + np[1536 + c] : 0.f;
#pragma unroll
    for (int m = 32; m >= 1; m >>= 1) { v0 += __shfl_xor(v0, m); v1 += __shfl_xor(v1, m); }
    if (lane == 0 && wave < 4) { misc[4 + wave] = v0; misc[8 + wave] = v1; }
  }
  if (tid < 68) ((unsigned*)Zrow)[tid] = 0u;
  hy_load_table(tbg, TbE, TbO, tid);
  const float* cw = p.conv_w + (size_t)l * 3 * 1536;
  const float* cbias = p.conv_b + (size_t)l * 1536;
  {
    const float w0 = cw[c], w1 = cw[1536 + c], w2 = cw[3072 + c], bs = cbias[c];
#pragma unroll
    for (int i = 0; i < 4; ++i) {
      const int q = tid + NT * i;
      const int bt = q >> 10, t8 = (q & 1023) * 8;
      const u16* row = p.hyT + (size_t)c * HYP + bt * SEQ;
      float o0[4], o1[4];
      sconv4(row, t8, w0, w1, w2, bs, o0);
      sconv4(row, t8 + 4, w0, w1, w2, bs, o1);
      uint4 ov;
      ov.x = pack2(o0[0], o0[1]); ov.y = pack2(o0[2], o0[3]); ov.z = pack2(o1[0], o1[1]); ov.w = pack2(o1[2], o1[3]);
      *(uint4*)(U + (bt * 64 + (t8 >> 7)) * 136 + (t8 & 127)) = ov;
    }
  }
  __syncthreads();
  const float invn0 = 1.0f / (misc[4] + misc[5] + misc[6] + misc[7]);
  const float invn1 = 1.0f / (misc[8] + misc[9] + misc[10] + misc[11]);
  const u16* abase = (li & 1) ? (TbO + (8192 - li + 8 * g - 1)) : (TbE + (8192 - li + 8 * g));
  const int bt = li >> 4;
  const int a = a0 + (li & 15);
  f32x16 acc[4];
  if (cwv) hy_conv(acc, abase, U, Zrow, a0, li, g);
  __syncthreads();
  if (cwv) {
    const float d0 = p.fbias[(size_t)(l * 2 + 0) * 512 + c];
    const float v0 = cw[c], v1 = cw[1536 + c], v2 = cw[3072 + c], vb = cbias[c];
    const float x0 = cw[512 + c], x1 = cw[1536 + 512 + c], x2 = cw[3072 + 512 + c], xb = cbias[512 + c];
    const u16* rowv = p.hyT + (size_t)c * HYP + bt * SEQ;
    const u16* rowx = p.hyT + (size_t)(512 + c) * HYP + bt * SEQ;
#pragma unroll
    for (int I = 0; I < 4; ++I)
#pragma unroll
      for (int rq = 0; rq < 4; ++rq) {
        const int bq = 32 * I + 8 * rq + 4 * g;
        const int t4 = 128 * a + bq;
        float pv[4], px[4];
        sconv4(rowv, t4, v0, v1, v2, vb, pv);
        sconv4(rowx, t4, x0, x1, x2, xb, px);
        float zz[4];
#pragma unroll
        for (int j = 0; j < 4; ++j) zz[j] = px[j] * (acc[I][4 * rq + j] * invn0 + pv[j] * d0);
        uint2 ov; ov.x = pack2(zz[0], zz[1]); ov.y = pack2(zz[2], zz[3]);
        *(uint2*)(U + (bt * 64 + a) * 136 + bq) = ov;
      }
  }
  hy_load_table(tbg + (size_t)512 * 16384, TbE, TbO, tid);
  __syncthreads();
  if (cwv) hy_conv(acc, abase, U, Zrow, a0, li, g);
  if (cwv) {
    const float d1 = p.fbias[(size_t)(l * 2 + 1) * 512 + c];
    const float x0 = cw[1024 + c], x1 = cw[1536 + 1024 + c], x2 = cw[3072 + 1024 + c], xb = cbias[1024 + c];
    const u16* rowx = p.hyT + (size_t)(1024 + c) * HYP + bt * SEQ;
    const u16* rowg = p.hyT + (size_t)(1536 + c) * HYP + bt * SEQ;
    u16* dst = p.YhT + (size_t)c * HYP + bt * SEQ;
#pragma unroll
    for (int I = 0; I < 4; ++I)
#pragma unroll
      for (int rq = 0; rq < 4; ++rq) {
        const int bq = 32 * I + 8 * rq + 4 * g;
        const int t4 = 128 * a + bq;
        float px[4];
        sconv4(rowx, t4, x0, x1, x2, xb, px);
        const uint2 zv = *(const uint2*)(U + (bt * 64 + a) * 136 + bq);
        const uint2 gv = *(const uint2*)(rowg + t4);
        const float z1[4] = {bflo(zv.x), bfhi(zv.x), bflo(zv.y), bfhi(zv.y)};
        const float gt[4] = {bflo(gv.x), bfhi(gv.x), bflo(gv.y), bfhi(gv.y)};
        float yy[4];
#pragma unroll
        for (int j = 0; j < 4; ++j) yy[j] = px[j] * (acc[I][4 * rq + j] * invn1 + z1[j] * d1) * siluf(gt[j]);
        uint2 ov; ov.x = pack2(yy[0], yy[1]); ov.y = pack2(yy[2], yy[3]);
        *(uint2*)(dst + t4) = ov;
      }
  }
}

DI void phase_mix(int l, char* smem, int lo = 0, int hi = 1024) {
  const P p = load_args();
  for (int it = lo + blockIdx.x; it < hi; it += gridDim.x) {
    __syncthreads();
    if (it < 512) attn_item(p, l, it, smem);
    else hyena_item(p, l, it - 512, smem);
  }
}

DI void phase_final() {
  const P p = load_args();
  const int tid = fresh_tid(), lane = tid & 63, wave = tid >> 6;
  const f32x4* gg = (const f32x4*)p.final_g;
  for (int rp = blockIdx.x * 8 + wave; rp < NTOK / 2; rp += gridDim.x * 8) {
    f32x4 v[2][4];
    f32x4 sq[2][2];
#pragma unroll
    for (int h2 = 0; h2 < 2; ++h2) {
      const int row = 2 * rp + h2;
      sq[h2][0] = ((const f32x4*)(p.ssq + (size_t)row * 8))[0];
      sq[h2][1] = ((const f32x4*)(p.ssq + (size_t)row * 8))[1];
#pragma unroll
      for (int i = 0; i < 4; ++i) {
        const uint2 hv = ((const uint2*)(p.hb + (size_t)row * 1024))[lane + 64 * i];
        f32x4 t; t[0] = bflo(hv.x); t[1] = bfhi(hv.x); t[2] = bflo(hv.y); t[3] = bfhi(hv.y);
        v[h2][i] = t;
      }
    }
#pragma unroll
    for (int h2 = 0; h2 < 2; ++h2) {
      const int row = 2 * rp + h2;
      const float s = sq[h2][0][0] + sq[h2][0][1] + sq[h2][0][2] + sq[h2][0][3] + sq[h2][1][0] + sq[h2][1][1] + sq[h2][1][2] + sq[h2][1][3];
      const float rs = rsqrtf(s * (1.0f / 1024.0f) + 1e-6f);
#pragma unroll
      for (int i = 0; i < 4; ++i) {
        const f32x4 w = gg[lane + 64 * i];
        f32x4 o = v[h2][i];
        o[0] *= rs * w[0]; o[1] *= rs * w[1]; o[2] *= rs * w[2]; o[3] *= rs * w[3];
        ((f32x4*)(p.out + (size_t)row * 1024))[lane + 64 * i] = o;
      }
    }
  }
}

#define XB_TMO      128
#define XB_XCNT(j)  (256  + 64 * (j))
#define XB_XSUB(j)  (1280 + 64 * (j))
#define XB_XGEN(j)  (2304 + 64 * (j))
#define XB_TOP      3328
#define XB_TOPGEN   3392
#define XCD_BAR_WORDS 3456
#define XB_SPIN_CAP (1u << 18)
#define LAS __attribute__((address_space(3)))

__device__ __forceinline__ unsigned xb_ld(unsigned* p)              { return __hip_atomic_load(p, __ATOMIC_RELAXED, __HIP_MEMORY_SCOPE_AGENT); }
__device__ __forceinline__ unsigned xb_add(unsigned* p, unsigned v) { return __hip_atomic_fetch_add(p, v, __ATOMIC_RELAXED, __HIP_MEMORY_SCOPE_AGENT); }
__device__ __forceinline__ unsigned xb_xcc_id() { return (unsigned)__builtin_amdgcn_s_getreg((3 << 11) | 20) & 0xFu; }
#define XB_SPIN(cond, bar) do { unsigned _sp = 0; while (cond) { __builtin_amdgcn_s_sleep(1); \
    if ((++_sp & 255u) == 0u) { if (xb_ld(&(bar)[XB_TMO])) break; if (_sp > XB_SPIN_CAP) { atomicAdd(&(bar)[XB_TMO], 1u); break; } } } } while (0)

struct XcdBarrier {
    unsigned* bar; unsigned x;
    volatile LAS unsigned* st;
};

__device__ __forceinline__ XcdBarrier xcd_barrier_post(unsigned* bar, volatile LAS unsigned* st) {
    XcdBarrier b; b.bar = bar; b.x = xb_xcc_id(); b.st = st;
    if (threadIdx.x == 0) (void)xb_add(&bar[XB_XCNT(b.x)], 1u);
    return b;
}
__device__ __forceinline__ void xcd_barrier_complete(unsigned* bar, unsigned x, unsigned& nloc, unsigned& nx) {
    const unsigned G = gridDim.x * gridDim.y * gridDim.z;
    unsigned sum, cnt, mine, sp = 0u;
    for (;;) {
        sum = 0u; cnt = 0u; mine = 0u;
#pragma unroll
        for (unsigned j = 0; j < 16; ++j) { const unsigned c = xb_ld(&bar[XB_XCNT(j)]); sum += c; cnt += (c > 0u) ? 1u : 0u; mine = (j == x) ? c : mine; }
        if (sum == G) break;
        __builtin_amdgcn_s_sleep(1);
        if ((++sp & 255u) == 0u) { if (xb_ld(&bar[XB_TMO])) break; if (sp > XB_SPIN_CAP) { atomicAdd(&bar[XB_TMO], 1u); break; } }
    }
    nloc = mine > 0u ? mine : 1u; nx = cnt > 0u ? cnt : 1u;
}

__device__ __forceinline__ void xcd_barrier(const XcdBarrier& b) {
    asm volatile("s_waitcnt vmcnt(0)" ::: "memory");
    __syncthreads();
    if (threadIdx.x == 0) {
        unsigned* bar = b.bar;
        __builtin_amdgcn_s_waitcnt(0);
        unsigned nloc = b.st[0], nx = b.st[1];
        if (nloc == 0u) { xcd_barrier_complete(bar, b.x, nloc, nx); b.st[0] = nloc; b.st[1] = nx; }
        const unsigned old = xb_add(&bar[XB_XSUB(b.x)], 1u);
        const unsigned gen = old / nloc;
        if (old + 1u == (gen + 1u) * nloc) {
            __builtin_amdgcn_fence(__ATOMIC_RELEASE, "agent");
            asm volatile("s_waitcnt vmcnt(0)" ::: "memory");
            const unsigned og = xb_add(&bar[XB_TOP], 1u);
            const unsigned tg = og / nx;
            if (og + 1u == (tg + 1u) * nx) xb_add(&bar[XB_TOPGEN], 1u);
            else XB_SPIN(xb_ld(&bar[XB_TOPGEN]) == tg, bar);
            __builtin_amdgcn_fence(__ATOMIC_ACQUIRE, "agent");
            xb_add(&bar[XB_XGEN(b.x)], 1u);
            asm volatile("s_waitcnt vmcnt(0)" ::: "memory");
        } else {
            XB_SPIN(xb_ld(&bar[XB_XGEN(b.x)]) == gen, bar);
            __builtin_amdgcn_fence(__ATOMIC_ACQUIRE, "agent");
            asm volatile("s_waitcnt vmcnt(0)" ::: "memory");
        }
    }
    __syncthreads();
}


#ifndef PH_MASK
#define PH_MASK 31
#endif
#ifndef REP_IN
#define REP_IN 0
#endif
#ifndef REP_FILT
#define REP_FILT 0
#endif
#ifndef REP_ATT
#define REP_ATT 0
#endif
#ifndef REP_HY
#define REP_HY 0
#endif
#ifndef REP_OUT0
#define REP_OUT0 0
#endif
__global__ void __launch_bounds__(NT) mega(P p) {
  extern __shared__ __attribute__((aligned(16))) char smem[];
  cg::grid_group grid = cg::this_grid();
  volatile LAS unsigned* xbw = (volatile LAS unsigned*)(smem + LDS_BYTES - 16);
  if (threadIdx.x < 4) xbw[threadIdx.x] = 0u;
  __syncthreads();
  unsigned* barw;
  { const P pa = load_args(); barw = pa.bar; }
  (void)xcd_barrier_post(barw, xbw);
  phase_prep(smem);
  grid.sync();
  for (int l = 0; l < 2; ++l) {
    for (int rep = 0; rep < REP_IN; ++rep) phase_in(l, smem, 0, 1024);
    for (int rep = 0; rep < REP_FILT; ++rep) phase_in(l, smem, 1024, 1280);
    phase_in(l, smem);
    { XcdBarrier b2; b2.bar = load_args().bar; b2.x = xb_xcc_id(); b2.st = (volatile LAS unsigned*)(smem + LDS_BYTES - 16); xcd_barrier(b2); }
    for (int rep = 0; rep < REP_ATT; ++rep) phase_mix(l, smem, 0, 512);
    for (int rep = 0; rep < REP_HY; ++rep) phase_mix(l, smem, 512, 1024);
    phase_mix(l, smem);
    { XcdBarrier b2; b2.bar = load_args().bar; b2.x = xb_xcc_id(); b2.st = (volatile LAS unsigned*)(smem + LDS_BYTES - 16); xcd_barrier(b2); }
    for (int rep = 0; rep < REP_OUT0; ++rep) if (l == 0) phase_out(l, smem);
    phase_out(l, smem);
    { XcdBarrier b2; b2.bar = load_args().bar; b2.x = xb_xcc_id(); b2.st = (volatile LAS unsigned*)(smem + LDS_BYTES - 16); xcd_barrier(b2); }
  }
  phase_final();
}

#if !SINGLE_LAUNCH
__global__ void __launch_bounds__(NT) k_phase(P p, int phase, int l) {
  extern __shared__ __attribute__((aligned(16))) char smem[];
  if (phase == 0) phase_prep(smem);
  else if (phase == 1) phase_in(l, smem);
  else if (phase == 2) phase_mix(l, smem);
  else if (phase == 3) phase_out(l, smem);
  else phase_final();
}
#endif

extern "C" void kernel_launch(void* const* d_in, const int* in_sizes, int n_in, void* d_out, int out_size, void* d_ws,
                              size_t ws_size, hipStream_t stream) {
  P p{};
  const float** fp = (const float**)&p;
  for (int i = 0; i < 21; ++i) fp[i] = (const float*)d_in[i];
  p.out = (float*)d_out;
  char* ws = (char*)d_ws;
  size_t off = 0;
  auto carve = [&](size_t bytes) { char* r = ws + off; off += (bytes + 255) & ~(size_t)255; return r; };
  p.WinT = (u16*)carve((size_t)2 * 4096 * 1024 * 2);
  p.WoutT = (u16*)carve((size_t)2 * 1024 * 1024 * 2);
  p.hb = (u16*)carve((size_t)NTOK * 1024 * 2);
  p.hyT = (u16*)carve((size_t)2048 * HYP * 2);
  p.Qb = (u16*)carve((size_t)NTOK * 512 * 2);
  p.Kb = (u16*)carve((size_t)NTOK * 512 * 2);
  p.VT = (u16*)carve((size_t)1024 * VTP * 2);
  p.AG = (u16*)carve((size_t)NTOK * 512 * 2);
  p.Ya = (u16*)carve((size_t)NTOK * 512 * 2);
  p.YhT = (u16*)carve((size_t)512 * HYP * 2);
  p.Tb = (u16*)carve((size_t)2 * 512 * 16384 * 2);
  p.ssq = (float*)carve((size_t)NTOK * 8 * 4);
  p.npart = (float*)carve((size_t)256 * 2048 * 4);
  p.rope = (float2*)carve((size_t)SEQ * 32 * 8);
  p.kmax = (unsigned*)carve(256);
  p.bar = (unsigned*)carve((size_t)XCD_BAR_WORDS * 4);
  if (off > ws_size) { fprintf(stderr, "workspace too small: need %zu have %zu\n", off, ws_size); return; }

  static int grid_blocks = 0;
  if (!grid_blocks) {
    int dev = 0, cus = 0, per_cu = 0;
    hipGetDevice(&dev);
    hipDeviceGetAttribute(&cus, hipDeviceAttributeMultiprocessorCount, dev);
    hipFuncSetAttribute((const void*)mega, hipFuncAttributeMaxDynamicSharedMemorySize, LDS_BYTES);
#if !SINGLE_LAUNCH
    hipFuncSetAttribute((const void*)k_phase, hipFuncAttributeMaxDynamicSharedMemorySize, LDS_BYTES);
#endif
    hipOccupancyMaxActiveBlocksPerMultiprocessor(&per_cu, mega, NT, LDS_BYTES);
    if (per_cu > 1) per_cu = 1;
    grid_blocks = cus * per_cu;
    if (grid_blocks <= 0) grid_blocks = 256;
  }
#if SINGLE_LAUNCH
  hipMemsetAsync(p.bar, 0, (size_t)XCD_BAR_WORDS * 4, stream);
  void* args[] = {&p};
  hipError_t e = hipLaunchCooperativeKernel((void*)mega, dim3(grid_blocks), dim3(NT), args, LDS_BYTES, stream);
  if (e != hipSuccess) fprintf(stderr, "cooperative launch failed: %s (grid %d)\n", hipGetErrorString(e), grid_blocks);
#else
  k_phase<<<grid_blocks, NT, LDS_BYTES, stream>>>(p, 0, 0);
  for (int l = 0; l < 2; ++l) {
    k_phase<<<grid_blocks, NT, LDS_BYTES, stream>>>(p, 1, l);
    k_phase<<<grid_blocks, NT, LDS_BYTES, stream>>>(p, 2, l);
    k_phase<<<grid_blocks, NT, LDS_BYTES, stream>>>(p, 3, l);
  }
  k_phase<<<grid_blocks, NT, LDS_BYTES, stream>>>(p, 4, 0);
#endif
}
```

```cpp
#include <hip/hip_runtime.h>
#include <hip/hip_cooperative_groups.h>
#include <cstdio>
namespace cg = cooperative_groups;

#ifndef SINGLE_LAUNCH
#define SINGLE_LAUNCH 1
#endif

typedef unsigned short u16;
using bf16x8 = __attribute__((ext_vector_type(8))) short;
using f32x16 = __attribute__((ext_vector_type(16))) float;
using u32x4 = __attribute__((ext_vector_type(4))) unsigned;
using f32x4 = __attribute__((ext_vector_type(4))) float;
typedef __bf16 bf2_t __attribute__((ext_vector_type(2)));
typedef float f2_t __attribute__((ext_vector_type(2)));
#define DI __device__ __forceinline__
DI int fresh_tid() { int t = threadIdx.x; asm volatile("" : "+v"(t)); return t; }
#define MFMA(a, b, c) __builtin_amdgcn_mfma_f32_32x32x16_bf16((a), (b), (c), 0, 0, 0)

constexpr int SEQ = 8192;
constexpr int NTOK = 16384;
constexpr int NT = 512;
constexpr int HYP = NTOK + 64;
constexpr int VTP = SEQ + 64;
constexpr int LDS_BYTES = 149504;

struct P {
  const float *x, *norm_g, *w_in, *conv_w, *conv_b, *fw1, *fb1, *fw2, *fb2, *fw3, *fb3, *ffreq, *fw4, *fbias,
      *lq1, *lk1, *lq2, *lk2, *subg, *w_out, *final_g;
  float* out;
  u16 *WinT, *WoutT, *hb, *hyT, *Qb, *Kb, *VT, *AG, *Ya, *YhT, *Tb;
  float *ssq, *npart;
  float2* rope;
  unsigned* kmax;
  unsigned* bar;
};

DI P load_args() {
#if defined(__HIP_DEVICE_COMPILE__)
  typedef const __attribute__((address_space(4))) P* kargp_t;
  kargp_t pp = (kargp_t)__builtin_amdgcn_kernarg_segment_ptr();
  asm volatile("" : "+s"(pp));
  return *pp;
#else
  return P{};
#endif
}

DI unsigned pack2(float a, float b) {
  f2_t v = {a, b};
  bf2_t r = __builtin_convertvector(v, bf2_t);
  return __builtin_bit_cast(unsigned, r);
}
DI u16 f2bf(float a) { return (u16)(pack2(a, 0.f) & 0xffffu); }
DI float bf2f(unsigned v) { return __uint_as_float(v << 16); }
DI float bflo(unsigned v) { return __uint_as_float(v << 16); }
DI float bfhi(unsigned v) { return __uint_as_float(v & 0xffff0000u); }
DI int crow(int reg, int g) { return (reg & 3) + 8 * (reg >> 2) + 4 * g; }
DI float siluf(float x) { return x * __builtin_amdgcn_rcpf(1.f + __expf(-x)); }
DI f32x16 zero16() { f32x16 z; for (int i = 0; i < 16; ++i) z[i] = 0.f; return z; }

DI void phase_prep(char* smem) {
  const P p = load_args();
  const int tid = threadIdx.x;
  {
    u16* T = (u16*)smem;
    const int kr = tid >> 4, nq = tid & 15;
    const int nr = tid >> 3, kq = tid & 7;
    for (int it = blockIdx.x; it < 2560; it += gridDim.x) {
      const int l = it / 1280, r = it % 1280;
      const float* W; u16* WT; int N; const float* gg; int tile;
      if (r < 1024) { W = p.w_in + (size_t)l * 1024 * 4096; WT = p.WinT + (size_t)l * 4096 * 1024; N = 4096; gg = p.norm_g + l * 1024; tile = r; }
      else { W = p.w_out + (size_t)l * 1024 * 1024; WT = p.WoutT + (size_t)l * 1024 * 1024; N = 1024; gg = nullptr; tile = r - 1024; }
      const int ntn = N / 64;
      const int tn = tile % ntn, tk = tile / ntn;
      const int n0 = tn * 64, k0 = tk * 64;
      const f32x4 va = *(const f32x4*)(W + (size_t)(k0 + kr) * N + n0 + 4 * nq);
      const f32x4 vb = *(const f32x4*)(W + (size_t)(k0 + kr + 32) * N + n0 + 4 * nq);
      const float ga = gg ? gg[k0 + kr] : 1.0f, gb = gg ? gg[k0 + kr + 32] : 1.0f;
      __syncthreads();
#pragma unroll
      for (int j = 0; j < 4; ++j) {
        T[kr * 66 + 4 * nq + j] = f2bf(va[j] * ga);
        T[(kr + 32) * 66 + 4 * nq + j] = f2bf(vb[j] * gb);
      }
      __syncthreads();
      u32x4 o;
#pragma unroll
      for (int j2 = 0; j2 < 4; ++j2)
        o[j2] = (unsigned)T[(8 * kq + 2 * j2) * 66 + nr] | ((unsigned)T[(8 * kq + 2 * j2 + 1) * 66 + nr] << 16);
      *(u32x4*)(WT + (size_t)(n0 + nr) * 1024 + k0 + 8 * kq) = o;
    }
    __syncthreads();
  }
  if (blockIdx.x == 0 && tid < 16) p.kmax[tid] = 0u;
  for (int i = blockIdx.x * NT + tid; i < SEQ * 32; i += gridDim.x * NT) {
    const int pos = i >> 5, j = i & 31;
    const float invf = exp2f(-(float)j * (13.287712379549449f / 32.0f));
    float sn, cs;
    sincosf((float)pos * invf, &sn, &cs);
    p.rope[i] = make_float2(cs, sn);
  }
  {
    const int lane = tid & 63, wave = tid >> 6;
    for (int rp = blockIdx.x * 8 + wave; rp < NTOK / 2; rp += gridDim.x * 8) {
      f32x4 v[2][4];
#pragma unroll
      for (int h2 = 0; h2 < 2; ++h2)
#pragma unroll
        for (int i = 0; i < 4; ++i) v[h2][i] = ((const f32x4*)(p.x + (size_t)(2 * rp + h2) * 1024))[lane + 64 * i];
#pragma unroll
      for (int h2 = 0; h2 < 2; ++h2) {
        const int row = 2 * rp + h2;
        float s = 0.f;
#pragma unroll
        for (int i = 0; i < 4; ++i) {
          const f32x4 w = v[h2][i];
          s += w[0] * w[0] + w[1] * w[1] + w[2] * w[2] + w[3] * w[3];
          uint2 o; o.x = pack2(w[0], w[1]); o.y = pack2(w[2], w[3]);
          *(uint2*)(p.hb + (size_t)row * 1024 + (lane + 64 * i) * 4) = o;
        }
#pragma unroll
        for (int m = 32; m >= 1; m >>= 1) s += __shfl_xor(s, m);
        if (lane < 8) p.ssq[row * 8 + lane] = (lane == 0) ? s : 0.f;
      }
    }
  }
}

DI void filter_tile(const P& p, int l, int tile, char* smem) {
  float* z = (float*)smem;
  float* h1 = z + 32 * 36;
  float* h2 = h1 + 32 * 68;
  u16* h3 = (u16*)(h2 + 32 * 68);
  const int tid = fresh_tid();
  const int m0 = tile * 32;
  for (int idx = tid; idx < 32 * 33; idx += NT) {
    const int pp = idx / 33, e = idx % 33;
    const int m = m0 + pp;
    float val;
    if (e == 0) val = (float)m / 8191.0f;
    else {
      const int j = (e - 1) & 15;
      const float fbj = 1e-4f + (float)j * ((15.0f - 1e-4f) / 15.0f);
      const float wpos = (6.283185307179586f * (float)m) / 8192.0f;
      const float ph = wpos * fbj;
      val = (e <= 16) ? cosf(ph) : -sinf(ph);
    }
    z[pp * 36 + e] = val;
  }
  const int r = tid & 63, pq = tid >> 6;
  const float fr = p.ffreq[l * 64 + r];
  float* Ws = (float*)(h3 + 32 * 72);
  f32x4 wq1[2], wq2[2], wq3[2];
  {
    const f32x4* w1 = (const f32x4*)(p.fw1 + l * 33 * 64);
    const f32x4* w2 = (const f32x4*)(p.fw2 + l * 64 * 64);
    const f32x4* w3 = (const f32x4*)(p.fw3 + l * 64 * 64);
#pragma unroll
    for (int i = 0; i < 2; ++i) { const int q = tid + NT * i; wq1[i] = w1[(q < 528) ? q : 0]; }
#pragma unroll
    for (int i = 0; i < 2; ++i) { wq2[i] = w2[tid + NT * i]; wq3[i] = w3[tid + NT * i]; }
  }
  const float b1v = p.fb1[l * 64 + r], b2v = p.fb2[l * 64 + r], b3v = p.fb3[l * 64 + r];
#pragma unroll
  for (int i = 0; i < 2; ++i) { const int q = tid + NT * i; if (q < 528) ((f32x4*)Ws)[q] = wq1[i]; }
  __syncthreads();
  {
    float s[4];
#pragma unroll
    for (int i = 0; i < 4; ++i) s[i] = b1v;
#pragma unroll 3
    for (int e = 0; e < 33; ++e) {
      const float wv = Ws[e * 64 + r];
#pragma unroll
      for (int i = 0; i < 4; ++i) s[i] += z[(pq + 8 * i) * 36 + e] * wv;
    }
#pragma unroll
    for (int i = 0; i < 4; ++i) h1[(pq + 8 * i) * 68 + r] = sinf(fr * s[i]);
  }
  __syncthreads();
#pragma unroll
  for (int i = 0; i < 2; ++i) ((f32x4*)Ws)[tid + NT * i] = wq2[i];
  __syncthreads();
  {
    float s[4];
#pragma unroll
    for (int i = 0; i < 4; ++i) s[i] = b2v;
#pragma unroll 4
    for (int e = 0; e < 64; ++e) {
      const float wv = Ws[e * 64 + r];
#pragma unroll
      for (int i = 0; i < 4; ++i) s[i] += h1[(pq + 8 * i) * 68 + e] * wv;
    }
#pragma unroll
    for (int i = 0; i < 4; ++i) h2[(pq + 8 * i) * 68 + r] = sinf(fr * s[i]);
  }
  __syncthreads();
#pragma unroll
  for (int i = 0; i < 2; ++i) ((f32x4*)Ws)[tid + NT * i] = wq3[i];
  __syncthreads();
  {
    float s[4];
#pragma unroll
    for (int i = 0; i < 4; ++i) s[i] = b3v;
#pragma unroll 4
    for (int e = 0; e < 64; ++e) {
      const float wv = Ws[e * 64 + r];
#pragma unroll
      for (int i = 0; i < 4; ++i) s[i] += h2[(pq + 8 * i) * 68 + e] * wv;
    }
#pragma unroll
    for (int i = 0; i < 4; ++i) h3[(pq + 8 * i) * 72 + r] = f2bf(sinf(fr * s[i]));
  }
  __syncthreads();
  const int lane = tid & 63, wave = tid >> 6, li = lane & 31, g = lane >> 5;
  bf16x8 af[4];
#pragma unroll
  for (int ks = 0; ks < 4; ++ks) af[ks] = *(const bf16x8*)(h3 + li * 72 + 16 * ks + 8 * g);
  const float* w4 = p.fw4 + (size_t)l * 64 * 2048;
  const float min_decay = -3.0701134573253944f, max_decay = -15.350567286626973f;
  for (int nb = 0; nb < 8; nb += 2) {
    u32x4 bw[2][4];
#pragma unroll
    for (int u = 0; u < 2; ++u) {
      const int col = wave * 256 + (nb + u) * 32 + li;
#pragma unroll
      for (int ks = 0; ks < 4; ++ks) {
        const float* wp = w4 + (size_t)(16 * ks + 8 * g) * 2048 + col;
        const float a0 = wp[0], a1 = wp[2048], a2 = wp[2 * 2048], a3 = wp[3 * 2048];
        const float a4 = wp[4 * 2048], a5 = wp[5 * 2048], a6 = wp[6 * 2048], a7 = wp[7 * 2048];
        u32x4 t; t[0] = pack2(a0, a1); t[1] = pack2(a2, a3); t[2] = pack2(a4, a5); t[3] = pack2(a6, a7);
        bw[u][ks] = t;
      }
    }
#pragma unroll
    for (int u = 0; u < 2; ++u) {
      const int col = wave * 256 + (nb + u) * 32 + li;
      f32x16 acc = zero16();
#pragma unroll
      for (int ks = 0; ks < 4; ++ks) acc = MFMA(af[ks], __builtin_bit_cast(bf16x8, bw[u][ks]), acc);
      const int j = col >> 9, c = col & 511;
      const int order = j & 1;
      const bool fwd = j < 2;
      const float delta = fabsf(min_decay + (float)c * ((max_decay - min_decay) / 511.0f));
      u16* tb = p.Tb + (size_t)(order * 512 + c) * 16384;
      float asum = 0.f;
#pragma unroll
      for (int reg = 0; reg < 16; ++reg) {
        const int m = m0 + crow(reg, g);
        const float t = (float)m / 8191.0f;
        const float v = acc[reg] * __expf(-t * delta);
        if (fwd) { tb[8192 - m] = f2bf(v); asum += fabsf(v); }
        else if (m >= 1) { tb[8192 + m] = f2bf(v); asum += fabsf(v); }
      }
      if (fwd && tile == 0 && g == 0) tb[0] = 0;
      asum += __shfl_xor(asum, 32);
      if (g == 0) p.npart[(size_t)tile * 2048 + col] = asum;
    }
  }
}

template <bool AT>
DI void gemm_main(f32x16 (&acc)[2][4], const u16* __restrict__ R, int ldr, const u16* __restrict__ Cm, int ldc,
                  const u16* __restrict__ RT, int ldrt, int K, char* smem, int tid) {
  constexpr int STG = 2 * 256 * 72;
  u16* S0 = (u16*)smem;
  const int lane = tid & 63, wave = tid >> 6, wr = wave >> 1, wc = wave & 1;
  const int li = lane & 31, g = lane >> 5;
  u32x4 rr[4], cr[4];
#pragma unroll
  for (int a = 0; a < 2; ++a)
#pragma unroll
    for (int b = 0; b < 4; ++b) acc[a][b] = zero16();
  const int nk = K / 64;
#pragma unroll
  for (int i = 0; i < 4; ++i) {
    const int cid = tid + NT * i;
    const int row = cid >> 3, kc = cid & 7;
    if (AT) {
      const int kr = cid >> 5, tc = cid & 31;
      rr[i] = *(const u32x4*)(RT + (size_t)kr * ldrt + tc * 8);
    } else {
      rr[i] = *(const u32x4*)(R + (size_t)row * ldr + kc * 8);
    }
    cr[i] = *(const u32x4*)(Cm + (size_t)row * ldc + kc * 8);
  }
  for (int kt = -1; kt < nk; ++kt) {
    if (kt + 1 < nk) {
      const int ks1 = kt + 1;
      u16* Rs = S0 + (ks1 & 1) * STG;
      u16* Cs = Rs + 256 * 72;
#pragma unroll
      for (int i = 0; i < 4; ++i) {
        const int cid = tid + NT * i;
        const int row = cid >> 3, kc = cid & 7;
        if (AT && ks1 < 8) {
          const int kr = cid >> 5, tc = cid & 31;
          *(u32x4*)(Rs + kr * 264 + tc * 8) = rr[i];
        } else {
          *(u32x4*)(Rs + row * 72 + kc * 8) = rr[i];
        }
        *(u32x4*)(Cs + row * 72 + kc * 8) = cr[i];
      }
    }
    if (kt + 2 < nk) {
      const int kn = kt + 2;
#pragma unroll
      for (int i = 0; i < 4; ++i) {
        const int cid = tid + NT * i;
        const int row = cid >> 3, kc = cid & 7;
        if (AT && kn < 8) {
          const int kr = cid >> 5, tc = cid & 31;
          rr[i] = *(const u32x4*)(RT + (size_t)(kn * 64 + kr) * ldrt + tc * 8);
        } else {
          rr[i] = *(const u32x4*)(R + (size_t)row * ldr + kn * 64 + kc * 8);
        }
        cr[i] = *(const u32x4*)(Cm + (size_t)row * ldc + kn * 64 + kc * 8);
      }
    }
    __builtin_amdgcn_sched_barrier(0);
    if (kt >= 0) {
      const u16* Rs = S0 + (kt & 1) * STG;
      const u16* Cs = Rs + 256 * 72;
      const u16* RTs = Rs;
#pragma unroll
      for (int ks = 0; ks < 4; ++ks) {
        bf16x8 rf[2];
#pragma unroll
        for (int rb = 0; rb < 2; ++rb) {
          if (AT && kt < 8) {
            const u16* src = RTs + (16 * ks + 8 * g) * 264 + 64 * wr + 32 * rb + li;
            bf16x8 t;
#pragma unroll
            for (int j = 0; j < 8; ++j) t[j] = (short)src[j * 264];
            rf[rb] = t;
          } else {
            rf[rb] = *(const bf16x8*)(Rs + (64 * wr + 32 * rb + li) * 72 + 16 * ks + 8 * g);
          }
        }
#pragma unroll
        for (int cb = 0; cb < 4; ++cb) {
          const bf16x8 cfv = *(const bf16x8*)(Cs + (128 * wc + 32 * cb + li) * 72 + 16 * ks + 8 * g);
#pragma unroll
          for (int rb = 0; rb < 2; ++rb) acc[rb][cb] = MFMA(rf[rb], cfv, acc[rb][cb]);
        }
      }
    }
    __syncthreads();
  }
}

template <bool TR>
DI void gemm_in_tile(const P& p, int l, int id, char* smem) {
  const int tid = fresh_tid(), lane = tid & 63, wave = tid >> 6, wr = wave >> 1, wc = wave & 1;
  const int li = lane & 31, g = lane >> 5;
  float* rs_s = (float*)(smem + 147456);
  const int kk = id >> 8, bx = id & 255, xcd = bx & 7, s = bx >> 3;
  const int mt = xcd * 8 + (s & 7), nt = 4 * kk + (s >> 3);
  const int m0 = mt * 256, n0 = nt * 256;
  constexpr bool tr = TR;
  if (tid < 256) {
    const float4* q = (const float4*)(p.ssq + (size_t)(m0 + tid) * 8);
    const float4 a = q[0], b = q[1];
    rs_s[tid] = rsqrtf((a.x + a.y + a.z + a.w + b.x + b.y + b.z + b.w) * (1.0f / 1024.0f) + 1e-6f);
  }
  const u16* A = p.hb + (size_t)m0 * 1024;
  const u16* B = p.WinT + (size_t)l * 4096 * 1024 + (size_t)n0 * 1024;
  f32x16 acc[2][4];
  if (TR) gemm_main<false>(acc, B, 1024, A, 1024, nullptr, 0, 1024, smem, tid);
  else gemm_main<false>(acc, A, 1024, B, 1024, nullptr, 0, 1024, smem, tid);
  if (tr) {
    const bool hy = nt < 8;
#pragma unroll
    for (int cb = 0; cb < 4; ++cb) {
      asm volatile("" ::: "memory");
      const int tl = 128 * wc + 32 * cb + li;
      const int tok = m0 + tl;
      const float rs = rs_s[tl];
      u16* dst = hy ? (p.hyT + (size_t)(n0 + 64 * wr) * HYP + tok)
                    : (p.VT + (size_t)((tok >> 13) * 512 + (n0 - 3072) + 64 * wr) * VTP + (tok & 8191));
      const size_t cstride = hy ? (size_t)HYP : (size_t)VTP;
#pragma unroll
      for (int rb = 0; rb < 2; ++rb) {
#pragma unroll
        for (int reg = 0; reg < 16; ++reg) {
          const int cl = 32 * rb + crow(reg, g);
          dst[(size_t)cl * cstride] = f2bf(acc[rb][cb][reg] * rs);
        }
      }
    }
  } else if (nt < 12) {
    const bool isq = nt < 10;
    const int h = (nt & 1) * 2 + wc;
    u16* dst = isq ? p.Qb : p.Kb;
    const float qs = isq ? (0.125f * 1.4426950408889634f) : 1.0f;
    float kl0 = 0.f, kl1 = 0.f;
#pragma unroll
    for (int rb = 0; rb < 2; ++rb) {
#pragma unroll
      for (int reg = 0; reg < 16; ++reg) {
        if ((reg & 7) == 0) asm volatile("" ::: "memory");
        const int rl = 64 * wr + 32 * rb + crow(reg, g);
        const int tok = m0 + rl;
        const float rs = rs_s[rl] * qs;
        const int pos = tok & 8191, b = tok >> 13;
        const float2 cs = p.rope[pos * 32 + li];
#pragma unroll
        for (int c = 0; c < 2; ++c) {
          const float x1 = acc[rb][2 * c][reg] * rs, x2 = acc[rb][2 * c + 1][reg] * rs;
          const float o1 = x1 * cs.x - x2 * cs.y, o2 = x2 * cs.x + x1 * cs.y;
          const size_t base = ((size_t)(((b * 4 + h) * 2 + c) * SEQ + pos)) * 64;
          dst[base + li] = f2bf(o1);
          dst[base + 32 + li] = f2bf(o2);
          if (c == 0) kl0 = fmaxf(kl0, o1 * o1 + o2 * o2); else kl1 = fmaxf(kl1, o1 * o1 + o2 * o2);
        }
      }
    }
    if (!isq) {
#pragma unroll
      for (int m = 16; m >= 1; m >>= 1) { kl0 += __shfl_xor(kl0, m); kl1 += __shfl_xor(kl1, m); }
      kl0 = fmaxf(kl0, __shfl_xor(kl0, 32)) * 1.02f;
      kl1 = fmaxf(kl1, __shfl_xor(kl1, 32)) * 1.02f;
      if (lane == 0) {
        atomicMax(p.kmax + (m0 >> 13) * 8 + h * 2 + 0, __float_as_uint(kl0));
        atomicMax(p.kmax + (m0 >> 13) * 8 + h * 2 + 1, __float_as_uint(kl1));
      }
    }
  } else {
#pragma unroll
    for (int rb = 0; rb < 2; ++rb) {
#pragma unroll
      for (int reg = 0; reg < 16; ++reg) {
        if ((reg & 7) == 0) asm volatile("" ::: "memory");
        const int rl = 64 * wr + 32 * rb + crow(reg, g);
        const int tok = m0 + rl;
        const float rs = rs_s[rl];
#pragma unroll
        for (int cb = 0; cb < 4; ++cb) {
          const int col = n0 - 3584 + 128 * wc + 32 * cb + li;
          p.AG[(size_t)tok * 512 + col] = f2bf(siluf(acc[rb][cb][reg] * rs));
        }
      }
    }
  }
}

DI void phase_in(int l, char* smem, int lo = 0, int hi = 1024 + 256) {
  const P p = load_args();
  for (int it = lo + blockIdx.x; it < hi; it += gridDim.x) {
    __syncthreads();
    if (it < 1024) {
      const int nt = 4 * (it >> 8) + ((it & 255) >> 6);
      if ((nt < 8) || (nt == 12) || (nt == 13)) gemm_in_tile<true>(p, l, it, smem);
      else gemm_in_tile<false>(p, l, it, smem);
    } else filter_tile(p, l, it - 1024, smem);
  }
}

DI void gemm_out_tile(const P& p, int l, int id, char* smem) {
  const int bx = id & 255, xcd = bx & 7, s = bx >> 3;
  const int mt = xcd * 8 + (s & 7), nt = s >> 3;
  const int m0 = mt * 256, n0 = nt * 256;
  const int tid = fresh_tid(), lane = tid & 63, wave = tid >> 6, wr = wave >> 1, wc = wave & 1;
  const int li = lane & 31, g = lane >> 5;
  f32x16 acc[2][4];
  const u16* R = p.Ya + (size_t)m0 * 512 - 512;
  const u16* Cm = p.WoutT + (size_t)l * 1024 * 1024 + (size_t)n0 * 1024;
  const u16* RT = p.YhT + m0;
  gemm_main<true>(acc, R, 512, Cm, 1024, RT, HYP, 1024, smem, tid);
  __syncthreads();
  float* red = (float*)smem;
#pragma unroll
  for (int rb = 0; rb < 2; ++rb) {
#pragma unroll
    for (int reg = 0; reg < 16; ++reg) {
      const int rl = 64 * wr + 32 * rb + crow(reg, g);
      const int tok = m0 + rl;
      float sacc = 0.f;
#pragma unroll
      for (int cb = 0; cb < 4; ++cb) {
        const int col = n0 + 128 * wc + 32 * cb + li;
        const size_t idx = (size_t)tok * 1024 + col;
        const float hn = bf2f((unsigned)p.hb[idx]) + acc[rb][cb][reg];
        p.hb[idx] = f2bf(hn);
        sacc += hn * hn;
      }
#pragma unroll
      for (int m = 16; m >= 1; m >>= 1) sacc += __shfl_xor(sacc, m);
      if (li == 0) red[wc * 256 + rl] = sacc;
    }
  }
  __syncthreads();
  if (tid < 256) {
    const float v = red[tid] + red[256 + tid];
    p.ssq[(size_t)(m0 + tid) * 8 + 2 * nt] = v;
    p.ssq[(size_t)(m0 + tid) * 8 + 2 * nt + 1] = 0.f;
  }
}

DI void phase_out(int l, char* smem) {
  const P p = load_args();
  for (int it = blockIdx.x; it < 256; it += gridDim.x) {
    __syncthreads();
    gemm_out_tile(p, l, it, smem);
  }
}

DI void attn_item(const P& p, int l, int item, char* smem) {
  u16* Ks = (u16*)smem;
  const int tid = fresh_tid(), lane = tid & 63, wave = tid >> 6;
  const int li = lane & 31, g = lane >> 5;
  const int qg = wave & 3, c = wave >> 2;
  const int bh = item & 7, qb = (item >> 8) * 32 + ((item & 255) >> 3);
  const int b = bh >> 2, h = bh & 3;
  const float lam_init = (l == 0) ? 0.2f : 0.35550906759096926f;
  float lam;
  {
    float s1 = p.lq1[l * 64 + lane] * p.lk1[l * 64 + lane];
    float s2 = p.lq2[l * 64 + lane] * p.lk2[l * 64 + lane];
#pragma unroll
    for (int m = 32; m >= 1; m >>= 1) { s1 += __shfl_xor(s1, m); s2 += __shfl_xor(s2, m); }
    lam = __expf(s1) - __expf(s2) + lam_init;
  }
  const int tq = qb * 128 + qg * 32 + li;
  bf16x8 qf[4];
  float negm;
  {
    float q2 = 0.f;
#pragma unroll
    for (int ks = 0; ks < 4; ++ks) {
      qf[ks] = *(const bf16x8*)(p.Qb + ((size_t)((bh * 2 + c) * SEQ + tq)) * 64 + 16 * ks + 8 * g);
#pragma unroll
      for (int j = 0; j < 8; ++j) { const float v = bf2f((unsigned)(u16)qf[ks][j]); q2 += v * v; }
    }
    q2 += __shfl_xor(q2, 32);
    const float k2 = __uint_as_float(p.kmax[bh * 2 + c]);
    negm = -(sqrtf(q2 * k2) * 1.01f + 1e-3f);
  }
  f32x16 O[4];
#pragma unroll
  for (int eb = 0; eb < 4; ++eb) O[eb] = zero16();
  float ls = 0.f;
  u32x4 kreg[2], vreg[2];
  const u16* kbase = p.Kb + (size_t)(bh * 2) * SEQ * 64;
  const u16* vbase = p.VT + (size_t)(bh * 128) * VTP;
#pragma unroll
  for (int i = 0; i < 2; ++i) kreg[i] = *(const u32x4*)(kbase + ((size_t)i * SEQ) * 64 + tid * 8);
#pragma unroll
  for (int i = 0; i < 2; ++i) {
    const int cid = tid + NT * i;
    const int e = cid >> 3, kc = cid & 7;
    vreg[i] = *(const u32x4*)(vbase + (size_t)e * VTP + kc * 8);
  }
  for (int kt = -1; kt < 128; ++kt) {
    if (kt + 1 < 128) {
      u16* Kd = Ks + ((kt + 1) & 1) * (256 * 72);
      u16* Vd = Kd + 2 * 64 * 72;
#pragma unroll
      for (int i = 0; i < 2; ++i) {
        const int row = tid >> 3, kc = tid & 7;
        *(u32x4*)(Kd + (i * 64 + row) * 72 + kc * 8) = kreg[i];
      }
#pragma unroll
      for (int i = 0; i < 2; ++i) {
        const int cid = tid + NT * i;
        const int e = cid >> 3, kc = cid & 7;
        uint2 w0; w0.x = vreg[i][0]; w0.y = vreg[i][1];
        uint2 w1; w1.x = vreg[i][2]; w1.y = vreg[i][3];
        u16* vd = Vd + e * 72 + (kc >> 1) * 16 + (kc & 1) * 4;
        *(uint2*)vd = w0;
        *(uint2*)(vd + 8) = w1;
      }
    }
    if (kt + 2 < 128) {
      const int kn = kt + 2;
#pragma unroll
      for (int i = 0; i < 2; ++i) kreg[i] = *(const u32x4*)(kbase + ((size_t)i * SEQ + kn * 64) * 64 + tid * 8);
#pragma unroll
      for (int i = 0; i < 2; ++i) {
        const int cid = tid + NT * i;
        const int e = cid >> 3, kc = cid & 7;
        vreg[i] = *(const u32x4*)(vbase + (size_t)e * VTP + kn * 64 + kc * 8);
      }
    }
    __builtin_amdgcn_sched_barrier(0);
    if (kt >= 0) {
      const u16* Kc = Ks + (kt & 1) * (256 * 72);
      const u16* Vc = Kc + 2 * 64 * 72;
      bf16x8 kf[8];
#pragma unroll
      for (int i = 0; i < 8; ++i)
        kf[i] = *(const bf16x8*)(Kc + (c * 64 + 32 * (i & 1) + li) * 72 + 16 * (i >> 1) + 8 * g);
      u32x4 vf[16];
#pragma unroll
      for (int i = 0; i < 16; ++i) {
        const int eb = i & 3, s = (i >> 2) & 1, kb = i >> 3;
        vf[i] = *(const u32x4*)(Vc + (32 * eb + li) * 72 + 32 * kb + 16 * s + 8 * g);
      }
      f32x16 S[2];
#pragma unroll
      for (int kb = 0; kb < 2; ++kb)
#pragma unroll
        for (int r = 0; r < 16; ++r) S[kb][r] = negm;
#pragma unroll
      for (int i = 0; i < 8; ++i) S[i & 1] = MFMA(kf[i], qf[i >> 1], S[i & 1]);
      u32x4 pk[4];
      float sum = 0.f;
#pragma unroll
      for (int ch = 0; ch < 4; ++ch) {
        const int kb = ch >> 1, s = ch & 1;
#pragma unroll
        for (int j2 = 0; j2 < 4; ++j2) {
          const float p0 = __builtin_amdgcn_exp2f(S[kb][8 * s + 2 * j2]);
          const float p1 = __builtin_amdgcn_exp2f(S[kb][8 * s + 2 * j2 + 1]);
          sum += p0 + p1;
          pk[ch][j2] = pack2(p0, p1);
        }
      }
      ls += sum;
#pragma unroll
      for (int i = 0; i < 16; ++i) {
        const int eb = i & 3, ch = i >> 2;
        O[eb] = MFMA(__builtin_bit_cast(bf16x8, vf[i]), __builtin_bit_cast(bf16x8, pk[ch]), O[eb]);
      }
    }
    __syncthreads();
  }
  const float lt = ls + __shfl_xor(ls, 32);
  const float inv = (c == 0) ? (1.0f / lt) : (lam / lt);
  float* exch = (float*)smem + qg * (64 * 64);
  if (c == 1) {
#pragma unroll
    for (int eb = 0; eb < 4; ++eb)
#pragma unroll
      for (int r = 0; r < 16; ++r) exch[(eb * 16 + r) * 64 + lane] = O[eb][r] * inv;
  }
  __syncthreads();
  if (c == 0) {
    float ss = 0.f;
#pragma unroll
    for (int eb = 0; eb < 4; ++eb)
#pragma unroll
      for (int r = 0; r < 16; ++r) {
        const float o = O[eb][r] * inv - exch[(eb * 16 + r) * 64 + lane];
        O[eb][r] = o;
        ss += o * o;
      }
    ss += __shfl_xor(ss, 32);
    const float rn = rsqrtf(ss * (1.0f / 128.0f) + 1e-5f) * (1.0f - lam_init);
    const size_t tok = (size_t)b * SEQ + tq;
#pragma unroll
    for (int eb = 0; eb < 4; ++eb)
#pragma unroll
      for (int rq = 0; rq < 4; ++rq) {
        const int e = 32 * eb + 8 * rq + 4 * g;
        const uint2 gt = *(const uint2*)(p.AG + tok * 512 + h * 128 + e);
        const float4 sg = *(const float4*)(p.subg + l * 128 + e);
        const float o0 = O[eb][4 * rq + 0] * rn * sg.x * bflo(gt.x);
        const float o1 = O[eb][4 * rq + 1] * rn * sg.y * bfhi(gt.x);
        const float o2 = O[eb][4 * rq + 2] * rn * sg.z * bflo(gt.y);
        const float o3 = O[eb][4 * rq + 3] * rn * sg.w * bfhi(gt.y);
        uint2 ov; ov.x = pack2(o0, o1); ov.y = pack2(o2, o3);
        *(uint2*)(p.Ya + tok * 512 + h * 128 + e) = ov;
      }
  }
}

DI void sconv4(const u16* row, int t4, float w0, float w1, float w2, float bias, float (&o)[4]) {
  const uint2 v = *(const uint2*)(row + t4);
  const float x0 = bflo(v.x), x1 = bfhi(v.x), x2 = bflo(v.y), x3 = bfhi(v.y);
  const float xm = (t4 > 0) ? bf2f(row[t4 - 1]) : 0.f;
  const float xp = (t4 + 4 < SEQ) ? bf2f(row[t4 + 4]) : 0.f;
  o[0] = w0 * xm + w1 * x0 + w2 * x1 + bias;
  o[1] = w0 * x0 + w1 * x1 + w2 * x2 + bias;
  o[2] = w0 * x1 + w1 * x2 + w2 * x3 + bias;
  o[3] = w0 * x2 + w1 * x3 + w2 * xp + bias;
}

DI void hy_load_table(const u16* __restrict__ tbg, u16* TbE, u16* TbO, int tid) {
#pragma unroll
  for (int i = 0; i < 4; ++i) {
    const int q = tid + NT * i;
    const uint4 v = *(const uint4*)(tbg + 8 * q);
    const unsigned nxt = (q < 2047) ? (unsigned)tbg[8 * q + 8] : 0u;
    *(uint4*)(TbE + 8 * q) = v;
    uint4 o;
    o.x = (v.x >> 16) | (v.y << 16);
    o.y = (v.y >> 16) | (v.z << 16);
    o.z = (v.z >> 16) | (v.w << 16);
    o.w = (v.w >> 16) | (nxt << 16);
    *(uint4*)(TbO + 8 * q) = o;
  }
}

DI u32x4 hy_afrag(const u16* abase, int f) {
  const unsigned* ap = (const unsigned*)(abase - 16 * f);
  u32x4 r; r[0] = ap[0]; r[1] = ap[1]; r[2] = ap[2]; r[3] = ap[3];
  return r;
}

DI void hy_bfrag(bf16x8 (&bf)[8], const u16* U, const u16* Zrow, int a0, int li, int g, int d) {
  const int ap = a0 + (li & 15) - d;
  const bool valid = (unsigned)ap < 64u;
  const u16* bb = valid ? (U + ((li >> 4) * 64 + ap) * 136 + 8 * g) : (Zrow + 8 * g);
#pragma unroll
  for (int kc = 0; kc < 8; ++kc) bf[kc] = *(const bf16x8*)(bb + 16 * kc);
}

DI void hy_conv(f32x16 (&acc)[4], const u16* abase, const u16* U, const u16* Zrow, int a0, int li, int g) {
#pragma unroll
  for (int i = 0; i < 4; ++i) acc[i] = zero16();
  u32x4 W[14];
  bf16x8 bf[8];
  int d = a0 - 63;
#pragma unroll
  for (int x = 0; x < 14; ++x) W[x] = hy_afrag(abase, 8 * d + x - 7);
  for (; d <= a0 + 15; ++d) {
    hy_bfrag(bf, U, Zrow, a0, li, g, d);
    u32x4 Wn[8];
    const int dn = (d < a0 + 15) ? d + 1 : d;
#pragma unroll
    for (int x = 0; x < 8; ++x) Wn[x] = hy_afrag(abase, 8 * dn + x - 1);
#pragma unroll
    for (int kc = 0; kc < 8; ++kc)
#pragma unroll
      for (int I = 0; I < 4; ++I) acc[I] = MFMA(__builtin_bit_cast(bf16x8, W[2 * I - kc + 7]), bf[kc], acc[I]);
#pragma unroll
    for (int x = 0; x < 6; ++x) W[x] = W[x + 8];
#pragma unroll
    for (int x = 0; x < 8; ++x) W[x + 6] = Wn[x];
  }
}

DI void hyena_item(const P& p, int l, int c, char* smem) {
  u16* TbE = (u16*)smem;
  u16* TbO = TbE + 16384 + 32;
  u16* U = TbO + 16384 + 32;
  u16* Zrow = U + 2 * 64 * 136;
  float* misc = (float*)(Zrow + 136);
  const int tid = fresh_tid(), lane = tid & 63, wave = tid >> 6;
  const int li = lane & 31, g = lane >> 5;
  const int a0 = 16 * (wave & 3);
  const bool cwv = wave < 4;
  const u16* tbg = p.Tb + (size_t)c * 16384;
  {
    const float* np = p.npart + (size_t)(tid & 255) * 2048;
    float v0 = (tid < 256) ? np[c] + np[1024 + c] : 0.f;
    float v1 = (tid < 256) ? np[512 + c] + np[1536 + c] : 0.f;
#pragma unroll
    for (int m = 32; m >= 1; m >>= 1) { v0 += __shfl_xor(v0, m); v1 += __shfl_xor(v1, m); }
    if (lane == 0 && wave < 4) { misc[4 + wave] = v0; misc[8 + wave] = v1; }
  }
  if (tid < 68) ((unsigned*)Zrow)[tid] = 0u;
  hy_load_table(tbg, TbE, TbO, tid);
  const float* cw = p.conv_w + (size_t)l * 3 * 1536;
  const float* cbias = p.conv_b + (size_t)l * 1536;
  {
    const float w0 = cw[c], w1 = cw[1536 + c], w2 = cw[3072 + c], bs = cbias[c];
#pragma unroll
    for (int i = 0; i < 4; ++i) {
      const int q = tid + NT * i;
      const int bt = q >> 10, t8 = (q & 1023) * 8;
      const u16* row = p.hyT + (size_t)c * HYP + bt * SEQ;
      float o0[4], o1[4];
      sconv4(row, t8, w0, w1, w2, bs, o0);
      sconv4(row, t8 + 4, w0, w1, w2, bs, o1);
      uint4 ov;
      ov.x = pack2(o0[0], o0[1]); ov.y = pack2(o0[2], o0[3]); ov.z = pack2(o1[0], o1[1]); ov.w = pack2(o1[2], o1[3]);
      *(uint4*)(U + (bt * 64 + (t8 >> 7)) * 136 + (t8 & 127)) = ov;
    }
  }
  __syncthreads();
  const float invn0 = 1.0f / (misc[4] + misc[5] + misc[6] + misc[7]);
  const float invn1 = 1.0f / (misc[8] + misc[9] + misc[10] + misc[11]);
  const u16* abase = (li & 1) ? (TbO + (8192 - li + 8 * g - 1)) : (TbE + (8192 - li + 8 * g));
  const int bt = li >> 4;
  const int a = a0 + (li & 15);
  f32x16 acc[4];
  if (cwv) hy_conv(acc, abase, U, Zrow, a0, li, g);
  __syncthreads();
  if (cwv) {
    const float d0 = p.fbias[(size_t)(l * 2 + 0) * 512 + c];
    const float v0 = cw[c], v1 = cw[1536 + c], v2 = cw[3072 + c], vb = cbias[c];
    const float x0 = cw[512 + c], x1 = cw[1536 + 512 + c], x2 = cw[3072 + 512 + c], xb = cbias[512 + c];
    const u16* rowv = p.hyT + (size_t)c * HYP + bt * SEQ;
    const u16* rowx = p.hyT + (size_t)(512 + c) * HYP + bt * SEQ;
#pragma unroll
    for (int I = 0; I < 4; ++I)
#pragma unroll
      for (int rq = 0; rq < 4; ++rq) {
        const int bq = 32 * I + 8 * rq + 4 * g;
        const int t4 = 128 * a + bq;
        float pv[4], px[4];
        sconv4(rowv, t4, v0, v1, v2, vb, pv);
        sconv4(rowx, t4, x0, x1, x2, xb, px);
        float zz[4];
#pragma unroll
        for (int j = 0; j < 4; ++j) zz[j] = px[j] * (acc[I][4 * rq + j] * invn0 + pv[j] * d0);
        uint2 ov; ov.x = pack2(zz[0], zz[1]); ov.y = pack2(zz[2], zz[3]);
        *(uint2*)(U + (bt * 64 + a) * 136 + bq) = ov;
      }
  }
  hy_load_table(tbg + (size_t)512 * 16384, TbE, TbO, tid);
  __syncthreads();
  if (cwv) hy_conv(acc, abase, U, Zrow, a0, li, g);
  if (cwv) {
    const float d1 = p.fbias[(size_t)(l * 2 + 1) * 512 + c];
    const float x0 = cw[1024 + c], x1 = cw[1536 + 1024 + c], x2 = cw[3072 + 1024 + c], xb = cbias[1024 + c];
    const u16* rowx = p.hyT + (size_t)(1024 + c) * HYP + bt * SEQ;
    const u16* rowg = p.hyT + (size_t)(1536 + c) * HYP + bt * SEQ;
    u16* dst = p.YhT + (size_t)c * HYP + bt * SEQ;
#pragma unroll
    for (int I = 0; I < 4; ++I)
#pragma unroll
      for (int rq = 0; rq < 4; ++rq) {
        const int bq = 32 * I + 8 * rq + 4 * g;
        const int t4 = 128 * a + bq;
        float px[4];
        sconv4(rowx, t4, x0, x1, x2, xb, px);
        const uint2 zv = *(const uint2*)(U + (bt * 64 + a) * 136 + bq);
        const uint2 gv = *(const uint2*)(rowg + t4);
        const float z1[4] = {bflo(zv.x), bfhi(zv.x), bflo(zv.y), bfhi(zv.y)};
        const float gt[4] = {bflo(gv.x), bfhi(gv.x), bflo(gv.y), bfhi(gv.y)};
        float yy[4];
#pragma unroll
        for (int j = 0; j < 4; ++j) yy[j] = px[j] * (acc[I][4 * rq + j] * invn1 + z1[j] * d1) * siluf(gt[j]);
        uint2 ov; ov.x = pack2(yy[0], yy[1]); ov.y = pack2(yy[2], yy[3]);
        *(uint2*)(dst + t4) = ov;
      }
  }
}

DI void phase_mix(int l, char* smem, int lo = 0, int hi = 1024) {
  const P p = load_args();
  for (int it = lo + blockIdx.x; it < hi; it += gridDim.x) {
    __syncthreads();
    if (it < 512) attn_item(p, l, it, smem);
    else hyena_item(p, l, it - 512, smem);
  }
}

DI void phase_final() {
  const P p = load_args();
  const int tid = fresh_tid(), lane = tid & 63, wave = tid >> 6;
  const f32x4* gg = (const f32x4*)p.final_g;
  for (int rp = blockIdx.x * 8 + wave; rp < NTOK / 2; rp += gridDim.x * 8) {
    f32x4 v[2][4];
    f32x4 sq[2][2];
#pragma unroll
    for (int h2 = 0; h2 < 2; ++h2) {
      const int row = 2 * rp + h2;
      sq[h2][0] = ((const f32x4*)(p.ssq + (size_t)row * 8))[0];
      sq[h2][1] = ((const f32x4*)(p.ssq + (size_t)row * 8))[1];
#pragma unroll
      for (int i = 0; i < 4; ++i) {
        const uint2 hv = ((const uint2*)(p.hb + (size_t)row * 1024))[lane + 64 * i];
        f32x4 t; t[0] = bflo(hv.x); t[1] = bfhi(hv.x); t[2] = bflo(hv.y); t[3] = bfhi(hv.y);
        v[h2][i] = t;
      }
    }
#pragma unroll
    for (int h2 = 0; h2 < 2; ++h2) {
      const int row = 2 * rp + h2;
      const float s = sq[h2][0][0] + sq[h2][0][1] + sq[h2][0][2] + sq[h2][0][3] + sq[h2][1][0] + sq[h2][1][1] + sq[h2][1][2] + sq[h2][1][3];
      const float rs = rsqrtf(s * (1.0f / 1024.0f) + 1e-6f);
#pragma unroll
      for (int i = 0; i < 4; ++i) {
        const f32x4 w = gg[lane + 64 * i];
        f32x4 o = v[h2][i];
        o[0] *= rs * w[0]; o[1] *= rs * w[1]; o[2] *= rs * w[2]; o[3] *= rs * w[3];
        ((f32x4*)(p.out + (size_t)row * 1024))[lane + 64 * i] = o;
      }
    }
  }
}

#define XB_TMO      128
#define XB_XCNT(j)  (256  + 64 * (j))
#define XB_XSUB(j)  (1280 + 64 * (j))
#define XB_XGEN(j)  (2304 + 64 * (j))
#define XB_TOP      3328
#define XB_TOPGEN   3392
#define XCD_BAR_WORDS 3456
#define XB_SPIN_CAP (1u << 18)
#define LAS __attribute__((address_space(3)))

__device__ __forceinline__ unsigned xb_ld(unsigned* p)              { return __hip_atomic_load(p, __ATOMIC_RELAXED, __HIP_MEMORY_SCOPE_AGENT); }
__device__ __forceinline__ unsigned xb_add(unsigned* p, unsigned v) { return __hip_atomic_fetch_add(p, v, __ATOMIC_RELAXED, __HIP_MEMORY_SCOPE_AGENT); }
__device__ __forceinline__ unsigned xb_xcc_id() { return (unsigned)__builtin_amdgcn_s_getreg((3 << 11) | 20) & 0xFu; }
#define XB_SPIN(cond, bar) do { unsigned _sp = 0; while (cond) { __builtin_amdgcn_s_sleep(1); \
    if ((++_sp & 255u) == 0u) { if (xb_ld(&(bar)[XB_TMO])) break; if (_sp > XB_SPIN_CAP) { atomicAdd(&(bar)[XB_TMO], 1u); break; } } } } while (0)

struct XcdBarrier {
    unsigned* bar; unsigned x;
    volatile LAS unsigned* st;
};

__device__ __forceinline__ XcdBarrier xcd_barrier_post(unsigned* bar, volatile LAS unsigned* st) {
    XcdBarrier b; b.bar = bar; b.x = xb_xcc_id(); b.st = st;
    if (threadIdx.x == 0) (void)xb_add(&bar[XB_XCNT(b.x)], 1u);
    return b;
}
__device__ __forceinline__ void xcd_barrier_complete(unsigned* bar, unsigned x, unsigned& nloc, unsigned& nx) {
    const unsigned G = gridDim.x * gridDim.y * gridDim.z;
    unsigned sum, cnt, mine, sp = 0u;
    for (;;) {
        sum = 0u; cnt = 0u; mine = 0u;
#pragma unroll
        for (unsigned j = 0; j < 16; ++j) { const unsigned c = xb_ld(&bar[XB_XCNT(j)]); sum += c; cnt += (c > 0u) ? 1u : 0u; mine = (j == x) ? c : mine; }
        if (sum == G) break;
        __builtin_amdgcn_s_sleep(1);
        if ((++sp & 255u) == 0u) { if (xb_ld(&bar[XB_TMO])) break; if (sp > XB_SPIN_CAP) { atomicAdd(&bar[XB_TMO], 1u); break; } }
    }
    nloc = mine > 0u ? mine : 1u; nx = cnt > 0u ? cnt : 1u;
}

__device__ __forceinline__ void xcd_barrier(const XcdBarrier& b) {
    asm volatile("s_waitcnt vmcnt(0)" ::: "memory");
    __syncthreads();
    if (threadIdx.x == 0) {
        unsigned* bar = b.bar;
        __builtin_amdgcn_s_waitcnt(0);
        unsigned nloc = b.st[0], nx = b.st[1];
        if (nloc == 0u) { xcd_barrier_complete(bar, b.x, nloc, nx); b.st[0] = nloc; b.st[1] = nx; }
        const unsigned old = xb_add(&bar[XB_XSUB(b.x)], 1u);
        const unsigned gen = old / nloc;
        if (old + 1u == (gen + 1u) * nloc) {
            __builtin_amdgcn_fence(__ATOMIC_RELEASE, "agent");
            asm volatile("s_waitcnt vmcnt(0)" ::: "memory");
            const unsigned og = xb_add(&bar[XB_TOP], 1u);
            const unsigned tg = og / nx;
            if (og + 1u == (tg + 1u) * nx) xb_add(&bar[XB_TOPGEN], 1u);
            else XB_SPIN(xb_ld(&bar[XB_TOPGEN]) == tg, bar);
            __builtin_amdgcn_fence(__ATOMIC_ACQUIRE, "agent");
            xb_add(&bar[XB_XGEN(b.x)], 1u);
            asm volatile("s_waitcnt vmcnt(0)" ::: "memory");
        } else {
            XB_SPIN(xb_ld(&bar[XB_XGEN(b.x)]) == gen, bar);
            __builtin_amdgcn_fence(__ATOMIC_ACQUIRE, "agent");
            asm volatile("s_waitcnt vmcnt(0)" ::: "memory");
        }
    }
    __syncthreads();
}


#ifndef PH_MASK
#define PH_MASK 31
#endif
#ifndef REP_IN
#define REP_IN 0
#endif
#ifndef REP_FILT
#define REP_FILT 0
#endif
#ifndef REP_ATT
#define REP_ATT 0
#endif
#ifndef REP_HY
#define REP_HY 0
#endif
#ifndef REP_OUT0
#define REP_OUT0 0
#endif
__global__ void __launch_bounds__(NT) mega(P p) {
  extern __shared__ __attribute__((aligned(16))) char smem[];
  cg::grid_group grid = cg::this_grid();
  volatile LAS unsigned* xbw = (volatile LAS unsigned*)(smem + LDS_BYTES - 16);
  if (threadIdx.x < 4) xbw[threadIdx.x] = 0u;
  __syncthreads();
  unsigned* barw;
  { const P pa = load_args(); barw = pa.bar; }
  (void)xcd_barrier_post(barw, xbw);
  phase_prep(smem);
  grid.sync();
  for (int l = 0; l < 2; ++l) {
    for (int rep = 0; rep < REP_IN; ++rep) phase_in(l, smem, 0, 1024);
    for (int rep = 0; rep < REP_FILT; ++rep) phase_in(l, smem, 1024, 1280);
    phase_in(l, smem);
    { XcdBarrier b2; b2.bar = load_args().bar; b2.x = xb_xcc_id(); b2.st = (volatile LAS unsigned*)(smem + LDS_BYTES - 16); xcd_barrier(b2); }
    for (int rep = 0; rep < REP_ATT; ++rep) phase_mix(l, smem, 0, 512);
    for (int rep = 0; rep < REP_HY; ++rep) phase_mix(l, smem, 512, 1024);
    phase_mix(l, smem);
    { XcdBarrier b2; b2.bar = load_args().bar; b2.x = xb_xcc_id(); b2.st = (volatile LAS unsigned*)(smem + LDS_BYTES - 16); xcd_barrier(b2); }
    for (int rep = 0; rep < REP_OUT0; ++rep) if (l == 0) phase_out(l, smem);
    phase_out(l, smem);
    { XcdBarrier b2; b2.bar = load_args().bar; b2.x = xb_xcc_id(); b2.st = (volatile LAS unsigned*)(smem + LDS_BYTES - 16); xcd_barrier(b2); }
  }
  phase_final();
}

#if !SINGLE_LAUNCH
__global__ void __launch_bounds__(NT) k_phase(P p, int phase, int l) {
  extern __shared__ __attribute__((aligned(16))) char smem[];
  if (phase == 0) phase_prep(smem);
  else if (phase == 1) phase_in(l, smem);
  else if (phase == 2) phase_mix(l, smem);
  else if (phase == 3) phase_out(l, smem);
  else phase_final();
}
#endif

extern "C" void kernel_launch(void* const* d_in, const int* in_sizes, int n_in, void* d_out, int out_size, void* d_ws,
                              size_t ws_size, hipStream_t stream) {
  P p{};
  const float** fp = (const float**)&p;
  for (int i = 0; i < 21; ++i) fp[i] = (const float*)d_in[i];
  p.out = (float*)d_out;
  char* ws = (char*)d_ws;
  size_t off = 0;
  auto carve = [&](size_t bytes) { char* r = ws + off; off += (bytes + 255) & ~(size_t)255; return r; };
  p.WinT = (u16*)carve((size_t)2 * 4096 * 1024 * 2);
  p.WoutT = (u16*)carve((size_t)2 * 1024 * 1024 * 2);
  p.hb = (u16*)carve((size_t)NTOK * 1024 * 2);
  p.hyT = (u16*)carve((size_t)2048 * HYP * 2);
  p.Qb = (u16*)carve((size_t)NTOK * 512 * 2);
  p.Kb = (u16*)carve((size_t)NTOK * 512 * 2);
  p.VT = (u16*)carve((size_t)1024 * VTP * 2);
  p.AG = (u16*)carve((size_t)NTOK * 512 * 2);
  p.Ya = (u16*)carve((size_t)NTOK * 512 * 2);
  p.YhT = (u16*)carve((size_t)512 * HYP * 2);
  p.Tb = (u16*)carve((size_t)2 * 512 * 16384 * 2);
  p.ssq = (float*)carve((size_t)NTOK * 8 * 4);
  p.npart = (float*)carve((size_t)256 * 2048 * 4);
  p.rope = (float2*)carve((size_t)SEQ * 32 * 8);
  p.kmax = (unsigned*)carve(256);
  p.bar = (unsigned*)carve((size_t)XCD_BAR_WORDS * 4);
  if (off > ws_size) { fprintf(stderr, "workspace too small: need %zu have %zu\n", off, ws_size); return; }

  static int grid_blocks = 0;
  if (!grid_blocks) {
    int dev = 0, cus = 0, per_cu = 0;
    hipGetDevice(&dev);
    hipDeviceGetAttribute(&cus, hipDeviceAttributeMultiprocessorCount, dev);
    hipFuncSetAttribute((const void*)mega, hipFuncAttributeMaxDynamicSharedMemorySize, LDS_BYTES);
#if !SINGLE_LAUNCH
    hipFuncSetAttribute((const void*)k_phase, hipFuncAttributeMaxDynamicSharedMemorySize, LDS_BYTES);
#endif
    hipOccupancyMaxActiveBlocksPerMultiprocessor(&per_cu, mega, NT, LDS_BYTES);
    if (per_cu > 1) per_cu = 1;
    grid_blocks = cus * per_cu;
    if (grid_blocks <= 0) grid_blocks = 256;
  }
#if SINGLE_LAUNCH
  hipMemsetAsync(p.bar, 0, (size_t)XCD_BAR_WORDS * 4, stream);
  void* args[] = {&p};
  hipError_t e = hipLaunchCooperativeKernel((void*)mega, dim3(grid_blocks), dim3(NT), args, LDS_BYTES, stream);
  if (e != hipSuccess) fprintf(stderr, "cooperative launch failed: %s (grid %d)\n", hipGetErrorString(e), grid_blocks);
#else
  k_phase<<<grid_blocks, NT, LDS_BYTES, stream>>>(p, 0, 0);
  for (int l = 0; l < 2; ++l) {
    k_phase<<<grid_blocks, NT, LDS_BYTES, stream>>>(p, 1, l);
    k_phase<<<grid_blocks, NT, LDS_BYTES, stream>>>(p, 2, l);
    k_phase<<<grid_blocks, NT, LDS_BYTES, stream>>>(p, 3, l);
  }
  k_phase<<<grid_blocks, NT, LDS_BYTES, stream>>>(p, 4, 0);
#endif
}
```

```cpp
#include <hip/hip_runtime.h>
#include <hip/hip_cooperative_groups.h>
#include <cstdio>
namespace cg = cooperative_groups;

#ifndef SINGLE_LAUNCH
#define SINGLE_LAUNCH 1
#endif

typedef unsigned short u16;
using bf16x8 = __attribute__((ext_vector_type(8))) short;
using f32x16 = __attribute__((ext_vector_type(16))) float;
using u32x4 = __attribute__((ext_vector_type(4))) unsigned;
using f32x4 = __attribute__((ext_vector_type(4))) float;
typedef __bf16 bf2_t __attribute__((ext_vector_type(2)));
typedef float f2_t __attribute__((ext_vector_type(2)));
#define DI __device__ __forceinline__
DI int fresh_tid() { int t = threadIdx.x; asm volatile("" : "+v"(t)); return t; }
#define MFMA(a, b, c) __builtin_amdgcn_mfma_f32_32x32x16_bf16((a), (b), (c), 0, 0, 0)

constexpr int SEQ = 8192;
constexpr int NTOK = 16384;
constexpr int NT = 512;
constexpr int HYP = NTOK + 64;
constexpr int VTP = SEQ + 64;
constexpr int LDS_BYTES = 149504;

struct P {
  const float *x, *norm_g, *w_in, *conv_w, *conv_b, *fw1, *fb1, *fw2, *fb2, *fw3, *fb3, *ffreq, *fw4, *fbias,
      *lq1, *lk1, *lq2, *lk2, *subg, *w_out, *final_g;
  float* out;
  u16 *WinT, *WoutT, *hb, *hyT, *Qb, *Kb, *VT, *AG, *Ya, *YhT, *Tb;
  float *ssq, *npart;
  float2* rope;
  unsigned* kmax;
  unsigned* bar;
};

DI P load_args() {
#if defined(__HIP_DEVICE_COMPILE__)
  typedef const __attribute__((address_space(4))) P* kargp_t;
  kargp_t pp = (kargp_t)__builtin_amdgcn_kernarg_segment_ptr();
  asm volatile("" : "+s"(pp));
  return *pp;
#else
  return P{};
#endif
}

DI unsigned pack2(float a, float b) {
  f2_t v = {a, b};
  bf2_t r = __builtin_convertvector(v, bf2_t);
  return __builtin_bit_cast(unsigned, r);
}
DI u16 f2bf(float a) { return (u16)(pack2(a, 0.f) & 0xffffu); }
DI float bf2f(unsigned v) { return __uint_as_float(v << 16); }
DI float bflo(unsigned v) { return __uint_as_float(v << 16); }
DI float bfhi(unsigned v) { return __uint_as_float(v & 0xffff0000u); }
DI int crow(int reg, int g) { return (reg & 3) + 8 * (reg >> 2) + 4 * g; }
DI float siluf(float x) { return x * __builtin_amdgcn_rcpf(1.f + __expf(-x)); }
DI f32x16 zero16() { f32x16 z; for (int i = 0; i < 16; ++i) z[i] = 0.f; return z; }

DI void phase_prep(char* smem) {
  const P p = load_args();
  const int tid = threadIdx.x;
  {
    u16* T = (u16*)smem;
    const int kr = tid >> 4, nq = tid & 15;
    const int nr = tid >> 3, kq = tid & 7;
    for (int it = blockIdx.x; it < 2560; it += gridDim.x) {
      const int l = it / 1280, r = it % 1280;
      const float* W; u16* WT; int N; const float* gg; int tile;
      if (r < 1024) { W = p.w_in + (size_t)l * 1024 * 4096; WT = p.WinT + (size_t)l * 4096 * 1024; N = 4096; gg = p.norm_g + l * 1024; tile = r; }
      else { W = p.w_out + (size_t)l * 1024 * 1024; WT = p.WoutT + (size_t)l * 1024 * 1024; N = 1024; gg = nullptr; tile = r - 1024; }
      const int ntn = N / 64;
      const int tn = tile % ntn, tk = tile / ntn;
      const int n0 = tn * 64, k0 = tk * 64;
      const f32x4 va = *(const f32x4*)(W + (size_t)(k0 + kr) * N + n0 + 4 * nq);
      const f32x4 vb = *(const f32x4*)(W + (size_t)(k0 + kr + 32) * N + n0 + 4 * nq);
      const float ga = gg ? gg[k0 + kr] : 1.0f, gb = gg ? gg[k0 + kr + 32] : 1.0f;
      __syncthreads();
#pragma unroll
      for (int j = 0; j < 4; ++j) {
        T[kr * 66 + 4 * nq + j] = f2bf(va[j] * ga);
        T[(kr + 32) * 66 + 4 * nq + j] = f2bf(vb[j] * gb);
      }
      __syncthreads();
      u32x4 o;
#pragma unroll
      for (int j2 = 0; j2 < 4; ++j2)
        o[j2] = (unsigned)T[(8 * kq + 2 * j2) * 66 + nr] | ((unsigned)T[(8 * kq + 2 * j2 + 1) * 66 + nr] << 16);
      *(u32x4*)(WT + (size_t)(n0 + nr) * 1024 + k0 + 8 * kq) = o;
    }
    __syncthreads();
  }
  if (blockIdx.x == 0 && tid < 16) p.kmax[tid] = 0u;
  for (int i = blockIdx.x * NT + tid; i < SEQ * 32; i += gridDim.x * NT) {
    const int pos = i >> 5, j = i & 31;
    const float invf = exp2f(-(float)j * (13.287712379549449f / 32.0f));
    float sn, cs;
    sincosf((float)pos * invf, &sn, &cs);
    p.rope[i] = make_float2(cs, sn);
  }
  {
    const int lane = tid & 63, wave = tid >> 6;
    for (int rp = blockIdx.x * 8 + wave; rp < NTOK / 2; rp += gridDim.x * 8) {
      f32x4 v[2][4];
#pragma unroll
      for (int h2 = 0; h2 < 2; ++h2)
#pragma unroll
        for (int i = 0; i < 4; ++i) v[h2][i] = ((const f32x4*)(p.x + (size_t)(2 * rp + h2) * 1024))[lane + 64 * i];
#pragma unroll
      for (int h2 = 0; h2 < 2; ++h2) {
        const int row = 2 * rp + h2;
        float s = 0.f;
#pragma unroll
        for (int i = 0; i < 4; ++i) {
          const f32x4 w = v[h2][i];
          s += w[0] * w[0] + w[1] * w[1] + w[2] * w[2] + w[3] * w[3];
          uint2 o; o.x = pack2(w[0], w[1]); o.y = pack2(w[2], w[3]);
          *(uint2*)(p.hb + (size_t)row * 1024 + (lane + 64 * i) * 4) = o;
        }
#pragma unroll
        for (int m = 32; m >= 1; m >>= 1) s += __shfl_xor(s, m);
        if (lane < 8) p.ssq[row * 8 + lane] = (lane == 0) ? s : 0.f;
      }
    }
  }
}

DI void filter_tile(const P& p, int l, int tile, char* smem) {
  float* z = (float*)smem;
  float* h1 = z + 32 * 36;
  float* h2 = h1 + 32 * 68;
  u16* h3 = (u16*)(h2 + 32 * 68);
  const int tid = fresh_tid();
  const int m0 = tile * 32;
  for (int idx = tid; idx < 32 * 33; idx += NT) {
    const int pp = idx / 33, e = idx % 33;
    const int m = m0 + pp;
    float val;
    if (e == 0) val = (float)m / 8191.0f;
    else {
      const int j = (e - 1) & 15;
      const float fbj = 1e-4f + (float)j * ((15.0f - 1e-4f) / 15.0f);
      const float wpos = (6.283185307179586f * (float)m) / 8192.0f;
      const float ph = wpos * fbj;
      val = (e <= 16) ? cosf(ph) : -sinf(ph);
    }
    z[pp * 36 + e] = val;
  }
  const int r = tid & 63, pq = tid >> 6;
  const float fr = p.ffreq[l * 64 + r];
  float* Ws = (float*)(h3 + 32 * 72);
  f32x4 wq1[2], wq2[2], wq3[2];
  {
    const f32x4* w1 = (const f32x4*)(p.fw1 + l * 33 * 64);
    const f32x4* w2 = (const f32x4*)(p.fw2 + l * 64 * 64);
    const f32x4* w3 = (const f32x4*)(p.fw3 + l * 64 * 64);
#pragma unroll
    for (int i = 0; i < 2; ++i) { const int q = tid + NT * i; wq1[i] = w1[(q < 528) ? q : 0]; }
#pragma unroll
    for (int i = 0; i < 2; ++i) { wq2[i] = w2[tid + NT * i]; wq3[i] = w3[tid + NT * i]; }
  }
  const float b1v = p.fb1[l * 64 + r], b2v = p.fb2[l * 64 + r], b3v = p.fb3[l * 64 + r];
#pragma unroll
  for (int i = 0; i < 2; ++i) { const int q = tid + NT * i; if (q < 528) ((f32x4*)Ws)[q] = wq1[i]; }
  __syncthreads();
  {
    float s[4];
#pragma unroll
    for (int i = 0; i < 4; ++i) s[i] = b1v;
#pragma unroll 3
    for (int e = 0; e < 33; ++e) {
      const float wv = Ws[e * 64 + r];
#pragma unroll
      for (int i = 0; i < 4; ++i) s[i] += z[(pq + 8 * i) * 36 + e] * wv;
    }
#pragma unroll
    for (int i = 0; i < 4; ++i) h1[(pq + 8 * i) * 68 + r] = sinf(fr * s[i]);
  }
  __syncthreads();
#pragma unroll
  for (int i = 0; i < 2; ++i) ((f32x4*)Ws)[tid + NT * i] = wq2[i];
  __syncthreads();
  {
    float s[4];
#pragma unroll
    for (int i = 0; i < 4; ++i) s[i] = b2v;
#pragma unroll 4
    for (int e = 0; e < 64; ++e) {
      const float wv = Ws[e * 64 + r];
#pragma unroll
      for (int i = 0; i < 4; ++i) s[i] += h1[(pq + 8 * i) * 68 + e] * wv;
    }
#pragma unroll
    for (int i = 0; i < 4; ++i) h2[(pq + 8 * i) * 68 + r] = sinf(fr * s[i]);
  }
  __syncthreads();
#pragma unroll
  for (int i = 0; i < 2; ++i) ((f32x4*)Ws)[tid + NT * i] = wq3[i];
  __syncthreads();
  {
    float s[4];
#pragma unroll
    for (int i = 0; i < 4; ++i) s[i] = b3v;
#pragma unroll 4
    for (int e = 0; e < 64; ++e) {
      const float wv = Ws[e * 64 + r];
#pragma unroll
      for (int i = 0; i < 4; ++i) s[i] += h2[(pq + 8 * i) * 68 + e] * wv;
    }
#pragma unroll
    for (int i = 0; i < 4; ++i) h3[(pq + 8 * i) * 72 + r] = f2bf(sinf(fr * s[i]));
  }
  __syncthreads();
  const int lane = tid & 63, wave = tid >> 6, li = lane & 31, g = lane >> 5;
  bf16x8 af[4];
#pragma unroll
  for (int ks = 0; ks < 4; ++ks) af[ks] = *(const bf16x8*)(h3 + li * 72 + 16 * ks + 8 * g);
  const float* w4 = p.fw4 + (size_t)l * 64 * 2048;
  const float min_decay = -3.0701134573253944f, max_decay = -15.350567286626973f;
  for (int nb = 0; nb < 8; nb += 2) {
    u32x4 bw[2][4];
#pragma unroll
    for (int u = 0; u < 2; ++u) {
      const int col = wave * 256 + (nb + u) * 32 + li;
#pragma unroll
      for (int ks = 0; ks < 4; ++ks) {
        const float* wp = w4 + (size_t)(16 * ks + 8 * g) * 2048 + col;
        const float a0 = wp[0], a1 = wp[2048], a2 = wp[2 * 2048], a3 = wp[3 * 2048];
        const float a4 = wp[4 * 2048], a5 = wp[5 * 2048], a6 = wp[6 * 2048], a7 = wp[7 * 2048];
        u32x4 t; t[0] = pack2(a0, a1); t[1] = pack2(a2, a3); t[2] = pack2(a4, a5); t[3] = pack2(a6, a7);
        bw[u][ks] = t;
      }
    }
#pragma unroll
    for (int u = 0; u < 2; ++u) {
      const int col = wave * 256 + (nb + u) * 32 + li;
      f32x16 acc = zero16();
#pragma unroll
      for (int ks = 0; ks < 4; ++ks) acc = MFMA(af[ks], __builtin_bit_cast(bf16x8, bw[u][ks]), acc);
      const int j = col >> 9, c = col & 511;
      const int order = j & 1;
      const bool fwd = j < 2;
      const float delta = fabsf(min_decay + (float)c * ((max_decay - min_decay) / 511.0f));
      u16* tb = p.Tb + (size_t)(order * 512 + c) * 16384;
      float asum = 0.f;
#pragma unroll
      for (int reg = 0; reg < 16; ++reg) {
        const int m = m0 + crow(reg, g);
        const float t = (float)m / 8191.0f;
        const float v = acc[reg] * __expf(-t * delta);
        if (fwd) { tb[8192 - m] = f2bf(v); asum += fabsf(v); }
        else if (m >= 1) { tb[8192 + m] = f2bf(v); asum += fabsf(v); }
      }
      if (fwd && tile == 0 && g == 0) tb[0] = 0;
      asum += __shfl_xor(asum, 32);
      if (g == 0) p.npart[(size_t)tile * 2048 + col] = asum;
    }
  }
}

template <bool AT>
DI void gemm_main(f32x16 (&acc)[2][4], const u16* __restrict__ R, int ldr, const u16* __restrict__ Cm, int ldc,
                  const u16* __restrict__ RT, int ldrt, int K, char* smem, int tid) {
  constexpr int STG = 2 * 256 * 72;
  u16* S0 = (u16*)smem;
  const int lane = tid & 63, wave = tid >> 6, wr = wave >> 1, wc = wave & 1;
  const int li = lane & 31, g = lane >> 5;
  u32x4 rr[4], cr[4];
#pragma unroll
  for (int a = 0; a < 2; ++a)
#pragma unroll
    for (int b = 0; b < 4; ++b) acc[a][b] = zero16();
  const int nk = K / 64;
#pragma unroll
  for (int i = 0; i < 4; ++i) {
    const int cid = tid + NT * i;
    const int row = cid >> 3, kc = cid & 7;
    if (AT) {
      const int kr = cid >> 5, tc = cid & 31;
      rr[i] = *(const u32x4*)(RT + (size_t)kr * ldrt + tc * 8);
    } else {
      rr[i] = *(const u32x4*)(R + (size_t)row * ldr + kc * 8);
    }
    cr[i] = *(const u32x4*)(Cm + (size_t)row * ldc + kc * 8);
  }
  for (int kt = -1; kt < nk; ++kt) {
    if (kt + 1 < nk) {
      const int ks1 = kt + 1;
      u16* Rs = S0 + (ks1 & 1) * STG;
      u16* Cs = Rs + 256 * 72;
#pragma unroll
      for (int i = 0; i < 4; ++i) {
        const int cid = tid + NT * i;
        const int row = cid >> 3, kc = cid & 7;
        if (AT && ks1 < 8) {
          const int kr = cid >> 5, tc = cid & 31;
          *(u32x4*)(Rs + kr * 264 + tc * 8) = rr[i];
        } else {
          *(u32x4*)(Rs + row * 72 + kc * 8) = rr[i];
        }
        *(u32x4*)(Cs + row * 72 + kc * 8) = cr[i];
      }
    }
    if (kt + 2 < nk) {
      const int kn = kt + 2;
#pragma unroll
      for (int i = 0; i < 4; ++i) {
        const int cid = tid + NT * i;
        const int row = cid >> 3, kc = cid & 7;
        if (AT && kn < 8) {
          const int kr = cid >> 5, tc = cid & 31;
          rr[i] = *(const u32x4*)(RT + (size_t)(kn * 64 + kr) * ldrt + tc * 8);
        } else {
          rr[i] = *(const u32x4*)(R + (size_t)row * ldr + kn * 64 + kc * 8);
        }
        cr[i] = *(const u32x4*)(Cm + (size_t)row * ldc + kn * 64 + kc * 8);
      }
    }
    __builtin_amdgcn_sched_barrier(0);
    if (kt >= 0) {
      const u16* Rs = S0 + (kt & 1) * STG;
      const u16* Cs = Rs + 256 * 72;
      const u16* RTs = Rs;
#pragma unroll
      for (int ks = 0; ks < 4; ++ks) {
        bf16x8 rf[2];
#pragma unroll
        for (int rb = 0; rb < 2; ++rb) {
          if (AT && kt < 8) {
            const u16* src = RTs + (16 * ks + 8 * g) * 264 + 64 * wr + 32 * rb + li;
            bf16x8 t;
#pragma unroll
            for (int j = 0; j < 8; ++j) t[j] = (short)src[j * 264];
            rf[rb] = t;
          } else {
            rf[rb] = *(const bf16x8*)(Rs + (64 * wr + 32 * rb + li) * 72 + 16 * ks + 8 * g);
          }
        }
#pragma unroll
        for (int cb = 0; cb < 4; ++cb) {
          const bf16x8 cfv = *(const bf16x8*)(Cs + (128 * wc + 32 * cb + li) * 72 + 16 * ks + 8 * g);
#pragma unroll
          for (int rb = 0; rb < 2; ++rb) acc[rb][cb] = MFMA(rf[rb], cfv, acc[rb][cb]);
        }
      }
    }
    __syncthreads();
  }
}

template <bool TR>
DI void gemm_in_tile(const P& p, int l, int id, char* smem) {
  const int tid = fresh_tid(), lane = tid & 63, wave = tid >> 6, wr = wave >> 1, wc = wave & 1;
  const int li = lane & 31, g = lane >> 5;
  float* rs_s = (float*)(smem + 147456);
  const int kk = id >> 8, bx = id & 255, xcd = bx & 7, s = bx >> 3;
  const int mt = xcd * 8 + (s & 7), nt = 4 * kk + (s >> 3);
  const int m0 = mt * 256, n0 = nt * 256;
  constexpr bool tr = TR;
  if (tid < 256) {
    const float4* q = (const float4*)(p.ssq + (size_t)(m0 + tid) * 8);
    const float4 a = q[0], b = q[1];
    rs_s[tid] = rsqrtf((a.x + a.y + a.z + a.w + b.x + b.y + b.z + b.w) * (1.0f / 1024.0f) + 1e-6f);
  }
  const u16* A = p.hb + (size_t)m0 * 1024;
  const u16* B = p.WinT + (size_t)l * 4096 * 1024 + (size_t)n0 * 1024;
  f32x16 acc[2][4];
  if (TR) gemm_main<false>(acc, B, 1024, A, 1024, nullptr, 0, 1024, smem, tid);
  else gemm_main<false>(acc, A, 1024, B, 1024, nullptr, 0, 1024, smem, tid);
  if (tr) {
    const bool hy = nt < 8;
#pragma unroll
    for (int cb = 0; cb < 4; ++cb) {
      asm volatile("" ::: "memory");
      const int tl = 128 * wc + 32 * cb + li;
      const int tok = m0 + tl;
      const float rs = rs_s[tl];
      u16* dst = hy ? (p.hyT + (size_t)(n0 + 64 * wr) * HYP + tok)
                    : (p.VT + (size_t)((tok >> 13) * 512 + (n0 - 3072) + 64 * wr) * VTP + (tok & 8191));
      const size_t cstride = hy ? (size_t)HYP : (size_t)VTP;
#pragma unroll
      for (int rb = 0; rb < 2; ++rb) {
#pragma unroll
        for (int reg = 0; reg < 16; ++reg) {
          const int cl = 32 * rb + crow(reg, g);
          dst[(size_t)cl * cstride] = f2bf(acc[rb][cb][reg] * rs);
        }
      }
    }
  } else if (nt < 12) {
    const bool isq = nt < 10;
    const int h = (nt & 1) * 2 + wc;
    u16* dst = isq ? p.Qb : p.Kb;
    const float qs = isq ? (0.125f * 1.4426950408889634f) : 1.0f;
    float kl0 = 0.f, kl1 = 0.f;
#pragma unroll
    for (int rb = 0; rb < 2; ++rb) {
#pragma unroll
      for (int reg = 0; reg < 16; ++reg) {
        if ((reg & 7) == 0) asm volatile("" ::: "memory");
        const int rl = 64 * wr + 32 * rb + crow(reg, g);
        const int tok = m0 + rl;
        const float rs = rs_s[rl] * qs;
        const int pos = tok & 8191, b = tok >> 13;
        const float2 cs = p.rope[pos * 32 + li];
#pragma unroll
        for (int c = 0; c < 2; ++c) {
          const float x1 = acc[rb][2 * c][reg] * rs, x2 = acc[rb][2 * c + 1][reg] * rs;
          const float o1 = x1 * cs.x - x2 * cs.y, o2 = x2 * cs.x + x1 * cs.y;
          const size_t base = ((size_t)(((b * 4 + h) * 2 + c) * SEQ + pos)) * 64;
          dst[base + li] = f2bf(o1);
          dst[base + 32 + li] = f2bf(o2);
          if (c == 0) kl0 = fmaxf(kl0, o1 * o1 + o2 * o2); else kl1 = fmaxf(kl1, o1 * o1 + o2 * o2);
        }
      }
    }
    if (!isq) {
#pragma unroll
      for (int m = 16; m >= 1; m >>= 1) { kl0 += __shfl_xor(kl0, m); kl1 += __shfl_xor(kl1, m); }
      kl0 = fmaxf(kl0, __shfl_xor(kl0, 32)) * 1.02f;
      kl1 = fmaxf(kl1, __shfl_xor(kl1, 32)) * 1.02f;
      if (lane == 0) {
        atomicMax(p.kmax + (m0 >> 13) * 8 + h * 2 + 0, __float_as_uint(kl0));
        atomicMax(p.kmax + (m0 >> 13) * 8 + h * 2 + 1, __float_as_uint(kl1));
      }
    }
  } else {
#pragma unroll
    for (int rb = 0; rb < 2; ++rb) {
#pragma unroll
      for (int reg = 0; reg < 16; ++reg) {
        if ((reg & 7) == 0) asm volatile("" ::: "memory");
        const int rl = 64 * wr + 32 * rb + crow(reg, g);
        const int tok = m0 + rl;
        const float rs = rs_s[rl];
#pragma unroll
        for (int cb = 0; cb < 4; ++cb) {
          const int col = n0 - 3584 + 128 * wc + 32 * cb + li;
          p.AG[(size_t)tok * 512 + col] = f2bf(siluf(acc[rb][cb][reg] * rs));
        }
      }
    }
  }
}

DI void phase_in(int l, char* smem, int lo = 0, int hi = 1024 + 256) {
  const P p = load_args();
  for (int it = lo + blockIdx.x; it < hi; it += gridDim.x) {
    __syncthreads();
    if (it < 1024) {
      const int nt = 4 * (it >> 8) + ((it & 255) >> 6);
      if ((nt < 8) || (nt == 12) || (nt == 13)) gemm_in_tile<true>(p, l, it, smem);
      else gemm_in_tile<false>(p, l, it, smem);
    } else filter_tile(p, l, it - 1024, smem);
  }
}

DI void gemm_out_tile(const P& p, int l, int id, char* smem) {
  const int bx = id & 255, xcd = bx & 7, s = bx >> 3;
  const int mt = xcd * 8 + (s & 7), nt = s >> 3;
  const int m0 = mt * 256, n0 = nt * 256;
  const int tid = fresh_tid(), lane = tid & 63, wave = tid >> 6, wr = wave >> 1, wc = wave & 1;
  const int li = lane & 31, g = lane >> 5;
  f32x16 acc[2][4];
  const u16* R = p.Ya + (size_t)m0 * 512 - 512;
  const u16* Cm = p.WoutT + (size_t)l * 1024 * 1024 + (size_t)n0 * 1024;
  const u16* RT = p.YhT + m0;
  gemm_main<true>(acc, R, 512, Cm, 1024, RT, HYP, 1024, smem, tid);
  __syncthreads();
  float* red = (float*)smem;
#pragma unroll
  for (int rb = 0; rb < 2; ++rb) {
#pragma unroll
    for (int reg = 0; reg < 16; ++reg) {
      const int rl = 64 * wr + 32 * rb + crow(reg, g);
      const int tok = m0 + rl;
      float sacc = 0.f;
#pragma unroll
      for (int cb = 0; cb < 4; ++cb) {
        const int col = n0 + 128 * wc + 32 * cb + li;
        const size_t idx = (size_t)tok * 1024 + col;
        const float hn = bf2f((unsigned)p.hb[idx]) + acc[rb][cb][reg];
        p.hb[idx] = f2bf(hn);
        sacc += hn * hn;
      }
#pragma unroll
      for (int m = 16; m >= 1; m >>= 1) sacc += __shfl_xor(sacc, m);
      if (li == 0) red[wc * 256 + rl] = sacc;
    }
  }
  __syncthreads();
  if (tid < 256) {
    const float v = red[tid] + red[256 + tid];
    p.ssq[(size_t)(m0 + tid) * 8 + 2 * nt] = v;
    p.ssq[(size_t)(m0 + tid) * 8 + 2 * nt + 1] = 0.f;
  }
}

DI void phase_out(int l, char* smem) {
  const P p = load_args();
  for (int it = blockIdx.x; it < 256; it += gridDim.x) {
    __syncthreads();
    gemm_out_tile(p, l, it, smem);
  }
}

DI void attn_item(const P& p, int l, int item, char* smem) {
  u16* Ks = (u16*)smem;
  const int tid = fresh_tid(), lane = tid & 63, wave = tid >> 6;
  const int li = lane & 31, g = lane >> 5;
  const int qg = wave & 3, c = wave >> 2;
  const int bh = item & 7, qb = (item >> 8) * 32 + ((item & 255) >> 3);
  const int b = bh >> 2, h = bh & 3;
  const float lam_init = (l == 0) ? 0.2f : 0.35550906759096926f;
  float lam;
  {
    float s1 = p.lq1[l * 64 + lane] * p.lk1[l * 64 + lane];
    float s2 = p.lq2[l * 64 + lane] * p.lk2[l * 64 + lane];
#pragma unroll
    for (int m = 32; m >= 1; m >>= 1) { s1 += __shfl_xor(s1, m); s2 += __shfl_xor(s2, m); }
    lam = __expf(s1) - __expf(s2) + lam_init;
  }
  const int tq = qb * 128 + qg * 32 + li;
  bf16x8 qf[4];
  float negm;
  {
    float q2 = 0.f;
#pragma unroll
    for (int ks = 0; ks < 4; ++ks) {
      qf[ks] = *(const bf16x8*)(p.Qb + ((size_t)((bh * 2 + c) * SEQ + tq)) * 64 + 16 * ks + 8 * g);
#pragma unroll
      for (int j = 0; j < 8; ++j) { const float v = bf2f((unsigned)(u16)qf[ks][j]); q2 += v * v; }
    }
    q2 += __shfl_xor(q2, 32);
    const float k2 = __uint_as_float(p.kmax[bh * 2 + c]);
    negm = -(sqrtf(q2 * k2) * 1.01f + 1e-3f);
  }
  f32x16 O[4];
#pragma unroll
  for (int eb = 0; eb < 4; ++eb) O[eb] = zero16();
  float ls = 0.f;
  u32x4 kreg[2], vreg[2];
  const u16* kbase = p.Kb + (size_t)(bh * 2) * SEQ * 64;
  const u16* vbase = p.VT + (size_t)(bh * 128) * VTP;
#pragma unroll
  for (int i = 0; i < 2; ++i) kreg[i] = *(const u32x4*)(kbase + ((size_t)i * SEQ) * 64 + tid * 8);
#pragma unroll
  for (int i = 0; i < 2; ++i) {
    const int cid = tid + NT * i;
    const int e = cid >> 3, kc = cid & 7;
    vreg[i] = *(const u32x4*)(vbase + (size_t)e * VTP + kc * 8);
  }
  for (int kt = -1; kt < 128; ++kt) {
    if (kt + 1 < 128) {
      u16* Kd = Ks + ((kt + 1) & 1) * (256 * 72);
      u16* Vd = Kd + 2 * 64 * 72;
#pragma unroll
      for (int i = 0; i < 2; ++i) {
        const int row = tid >> 3, kc = tid & 7;
        *(u32x4*)(Kd + (i * 64 + row) * 72 + kc * 8) = kreg[i];
      }
#pragma unroll
      for (int i = 0; i < 2; ++i) {
        const int cid = tid + NT * i;
        const int e = cid >> 3, kc = cid & 7;
        uint2 w0; w0.x = vreg[i][0]; w0.y = vreg[i][1];
        uint2 w1; w1.x = vreg[i][2]; w1.y = vreg[i][3];
        u16* vd = Vd + e * 72 + (kc >> 1) * 16 + (kc & 1) * 4;
        *(uint2*)vd = w0;
        *(uint2*)(vd + 8) = w1;
      }
    }
    if (kt + 2 < 128) {
      const int kn = kt + 2;
#pragma unroll
      for (int i = 0; i < 2; ++i) kreg[i] = *(const u32x4*)(kbase + ((size_t)i * SEQ + kn * 64) * 64 + tid * 8);
#pragma unroll
      for (int i = 0; i < 2; ++i) {
        const int cid = tid + NT * i;
        const int e = cid >> 3, kc = cid & 7;
        vreg[i] = *(const u32x4*)(vbase + (size_t)e * VTP + kn * 64 + kc * 8);
      }
    }
    __builtin_amdgcn_sched_barrier(0);
    if (kt >= 0) {
      const u16* Kc = Ks + (kt & 1) * (256 * 72);
      const u16* Vc = Kc + 2 * 64 * 72;
      bf16x8 kf[8];
#pragma unroll
      for (int i = 0; i < 8; ++i)
        kf[i] = *(const bf16x8*)(Kc + (c * 64 + 32 * (i & 1) + li) * 72 + 16 * (i >> 1) + 8 * g);
      u32x4 vf[16];
#pragma unroll
      for (int i = 0; i < 16; ++i) {
        const int eb = i & 3, s = (i >> 2) & 1, kb = i >> 3;
        vf[i] = *(const u32x4*)(Vc + (32 * eb + li) * 72 + 32 * kb + 16 * s + 8 * g);
      }
      f32x16 S[2];
#pragma unroll
      for (int kb = 0; kb < 2; ++kb)
#pragma unroll
        for (int r = 0; r < 16; ++r) S[kb][r] = negm;
#pragma unroll
      for (int i = 0; i < 8; ++i) S[i & 1] = MFMA(kf[i], qf[i >> 1], S[i & 1]);
      u32x4 pk[4];
      float sum = 0.f;
#pragma unroll
      for (int ch = 0; ch < 4; ++ch) {
        const int kb = ch >> 1, s = ch & 1;
#pragma unroll
        for (int j2 = 0; j2 < 4; ++j2) {
          const float p0 = __builtin_amdgcn_exp2f(S[kb][8 * s + 2 * j2]);
          const float p1 = __builtin_amdgcn_exp2f(S[kb][8 * s + 2 * j2 + 1]);
          sum += p0 + p1;
          pk[ch][j2] = pack2(p0, p1);
        }
      }
      ls += sum;
#pragma unroll
      for (int i = 0; i < 16; ++i) {
        const int eb = i & 3, ch = i >> 2;
        O[eb] = MFMA(__builtin_bit_cast(bf16x8, vf[i]), __builtin_bit_cast(bf16x8, pk[ch]), O[eb]);
      }
    }
    __syncthreads();
  }
  const float lt = ls + __shfl_xor(ls, 32);
  const float inv = (c == 0) ? (1.0f / lt) : (lam / lt);
  float* exch = (float*)smem + qg * (64 * 64);
  if (c == 1) {
#pragma unroll
    for (int eb = 0; eb < 4; ++eb)
#pragma unroll
      for (int r = 0; r < 16; ++r) exch[(eb * 16 + r) * 64 + lane] = O[eb][r] * inv;
  }
  __syncthreads();
  if (c == 0) {
    float ss = 0.f;
#pragma unroll
    for (int eb = 0; eb < 4; ++eb)
#pragma unroll
      for (int r = 0; r < 16; ++r) {
        const float o = O[eb][r] * inv - exch[(eb * 16 + r) * 64 + lane];
        O[eb][r] = o;
        ss += o * o;
      }
    ss += __shfl_xor(ss, 32);
    const float rn = rsqrtf(ss * (1.0f / 128.0f) + 1e-5f) * (1.0f - lam_init);
    const size_t tok = (size_t)b * SEQ + tq;
#pragma unroll
    for (int eb = 0; eb < 4; ++eb)
#pragma unroll
      for (int rq = 0; rq < 4; ++rq) {
        const int e = 32 * eb + 8 * rq + 4 * g;
        const uint2 gt = *(const uint2*)(p.AG + tok * 512 + h * 128 + e);
        const float4 sg = *(const float4*)(p.subg + l * 128 + e);
        const float o0 = O[eb][4 * rq + 0] * rn * sg.x * bflo(gt.x);
        const float o1 = O[eb][4 * rq + 1] * rn * sg.y * bfhi(gt.x);
        const float o2 = O[eb][4 * rq + 2] * rn * sg.z * bflo(gt.y);
        const float o3 = O[eb][4 * rq + 3] * rn * sg.w * bfhi(gt.y);
        uint2 ov; ov.x = pack2(o0, o1); ov.y = pack2(o2, o3);
        *(uint2*)(p.Ya + tok * 512 + h * 128 + e) = ov;
      }
  }
}

DI void sconv4(const u16* row, int t4, float w0, float w1, float w2, float bias, float (&o)[4]) {
  const uint2 v = *(const uint2*)(row + t4);
  const float x0 = bflo(v.x), x1 = bfhi(v.x), x2 = bflo(v.y), x3 = bfhi(v.y);
  const float xm = (t4 > 0) ? bf2f(row[t4 - 1]) : 0.f;
  const float xp = (t4 + 4 < SEQ) ? bf2f(row[t4 + 4]) : 0.f;
  o[0] = w0 * xm + w1 * x0 + w2 * x1 + bias;
  o[1] = w0 * x0 + w1 * x1 + w2 * x2 + bias;
  o[2] = w0 * x1 + w1 * x2 + w2 * x3 + bias;
  o[3] = w0 * x2 + w1 * x3 + w2 * xp + bias;
}

DI void hy_load_table(const u16* __restrict__ tbg, u16* TbE, u16* TbO, int tid) {
#pragma unroll
  for (int i = 0; i < 4; ++i) {
    const int q = tid + NT * i;
    const uint4 v = *(const uint4*)(tbg + 8 * q);
    const unsigned nxt = (q < 2047) ? (unsigned)tbg[8 * q + 8] : 0u;
    *(uint4*)(TbE + 8 * q) = v;
    uint4 o;
    o.x = (v.x >> 16) | (v.y << 16);
    o.y = (v.y >> 16) | (v.z << 16);
    o.z = (v.z >> 16) | (v.w << 16);
    o.w = (v.w >> 16) | (nxt << 16);
    *(uint4*)(TbO + 8 * q) = o;
  }
}

DI u32x4 hy_afrag(const u16* abase, int f) {
  const unsigned* ap = (const unsigned*)(abase - 16 * f);
  u32x4 r; r[0] = ap[0]; r[1] = ap[1]; r[2] = ap[2]; r[3] = ap[3];
  return r;
}

DI void hy_bfrag(bf16x8 (&bf)[8], const u16* U, const u16* Zrow, int a0, int li, int g, int d) {
  const int ap = a0 + (li & 15) - d;
  const bool valid = (unsigned)ap < 64u;
  const u16* bb = valid ? (U + ((li >> 4) * 64 + ap) * 136 + 8 * g) : (Zrow + 8 * g);
#pragma unroll
  for (int kc = 0; kc < 8; ++kc) bf[kc] = *(const bf16x8*)(bb + 16 * kc);
}

DI void hy_conv(f32x16 (&acc)[4], const u16* abase, const u16* U, const u16* Zrow, int a0, int li, int g) {
#pragma unroll
  for (int i = 0; i < 4; ++i) acc[i] = zero16();
  u32x4 W[14];
  bf16x8 bf[8];
  int d = a0 - 63;
#pragma unroll
  for (int x = 0; x < 14; ++x) W[x] = hy_afrag(abase, 8 * d + x - 7);
  for (; d <= a0 + 15; ++d) {
    hy_bfrag(bf, U, Zrow, a0, li, g, d);
    u32x4 Wn[8];
    const int dn = (d < a0 + 15) ? d + 1 : d;
#pragma unroll
    for (int x = 0; x < 8; ++x) Wn[x] = hy_afrag(abase, 8 * dn + x - 1);
#pragma unroll
    for (int kc = 0; kc < 8; ++kc)
#pragma unroll
      for (int I = 0; I < 4; ++I) acc[I] = MFMA(__builtin_bit_cast(bf16x8, W[2 * I - kc + 7]), bf[kc], acc[I]);
#pragma unroll
    for (int x = 0; x < 6; ++x) W[x] = W[x + 8];
#pragma unroll
    for (int x = 0; x < 8; ++x) W[x + 6] = Wn[x];
  }
}

DI void hyena_item(const P& p, int l, int c, char* smem) {
  u16* TbE = (u16*)smem;
  u16* TbO = TbE + 16384 + 32;
  u16* U = TbO + 16384 + 32;
  u16* Zrow = U + 2 * 64 * 136;
  float* misc = (float*)(Zrow + 136);
  const int tid = fresh_tid(), lane = tid & 63, wave = tid >> 6;
  const int li = lane & 31, g = lane >> 5;
  const int a0 = 16 * (wave & 3);
  const bool cwv = wave < 4;
  const u16* tbg = p.Tb + (size_t)c * 16384;
  {
    const float* np = p.npart + (size_t)(tid & 255) * 2048;
    float v0 = (tid < 256) ? np[c] + np[1024 + c] : 0.f;
    float v1 = (tid < 256) ? np[512 + c] + np[1536 + c] : 0.f;
#pragma unroll
    for (int m = 32; m >= 1; m >>= 1) { v0 += __shfl_xor(v0, m); v1 += __shfl_xor(v1, m); }
    if (lane == 0 && wave < 4) { misc[4 + wave] = v0; misc[8 + wave] = v1; }
  }
  if (tid < 68) ((unsigned*)Zrow)[tid] = 0u;
  hy_load_table(tbg, TbE, TbO, tid);
  const float* cw = p.conv_w + (size_t)l * 3 * 1536;
  const float* cbias = p.conv_b + (size_t)l * 1536;
  {
    const float w0 = cw[c], w1 = cw[1536 + c], w2 = cw[3072 + c], bs = cbias[c];
#pragma unroll
    for (int i = 0; i < 4; ++i) {
      const int q = tid + NT * i;
      const int bt = q >> 10, t8 = (q & 1023) * 8;
      const u16* row = p.hyT + (size_t)c * HYP + bt * SEQ;
      float o0[4], o1[4];
      sconv4(row, t8, w0, w1, w2, bs, o0);
      sconv4(row, t8 + 4, w0, w1, w2, bs, o1);
      uint4 ov;
      ov.x = pack2(o0[0], o0[1]); ov.y = pack2(o0[2], o0[3]); ov.z = pack2(o1[0], o1[1]); ov.w = pack2(o1[2], o1[3]);
      *(uint4*)(U + (bt * 64 + (t8 >> 7)) * 136 + (t8 & 127)) = ov;
    }
  }
  __syncthreads();
  const float invn0 = 1.0f / (misc[4] + misc[5] + misc[6] + misc[7]);
  const float invn1 = 1.0f / (misc[8] + misc[9] + misc[10] + misc[11]);
  const u16* abase = (li & 1) ? (TbO + (8192 - li + 8 * g - 1)) : (TbE + (8192 - li + 8 * g));
  const int bt = li >> 4;
  const int a = a0 + (li & 15);
  f32x16 acc[4];
  if (cwv) hy_conv(acc, abase, U, Zrow, a0, li, g);
  __syncthreads();
  if (cwv) {
    const float d0 = p.fbias[(size_t)(l * 2 + 0) * 512 + c];
    const float v0 = cw[c], v1 = cw[1536 + c], v2 = cw[3072 + c], vb = cbias[c];
    const float x0 = cw[512 + c], x1 = cw[1536 + 512 + c], x2 = cw[3072 + 512 + c], xb = cbias[512 + c];
    const u16* rowv = p.hyT + (size_t)c * HYP + bt * SEQ;
    const u16* rowx = p.hyT + (size_t)(512 + c) * HYP + bt * SEQ;
#pragma unroll
    for (int I = 0; I < 4; ++I)
#pragma unroll
      for (int rq = 0; rq < 4; ++rq) {
        const int bq = 32 * I + 8 * rq + 4 * g;
        const int t4 = 128 * a + bq;
        float pv[4], px[4];
        sconv4(rowv, t4, v0, v1, v2, vb, pv);
        sconv4(rowx, t4, x0, x1, x2, xb, px);
        float zz[4];
#pragma unroll
        for (int j = 0; j < 4; ++j) zz[j] = px[j] * (acc[I][4 * rq + j] * invn0 + pv[j] * d0);
        uint2 ov; ov.x = pack2(zz[0], zz[1]); ov.y = pack2(zz[2], zz[3]);
        *(uint2*)(U + (bt * 64 + a) * 136 + bq) = ov;
      }
  }
  hy_load_table(tbg + (size_t)512 * 16384, TbE, TbO, tid);
  __syncthreads();
  if (cwv) hy_conv(acc, abase, U, Zrow, a0, li, g);
  if (cwv) {
    const float d1 = p.fbias[(size_t)(l * 2 + 1) * 512 + c];
    const float x0 = cw[1024 + c], x1 = cw[1536 + 1024 + c], x2 = cw[3072 + 1024 + c], xb = cbias[1024 + c];
    const u16* rowx = p.hyT + (size_t)(1024 + c) * HYP + bt * SEQ;
    const u16* rowg = p.hyT + (size_t)(1536 + c) * HYP + bt * SEQ;
    u16* dst = p.YhT + (size_t)c * HYP + bt * SEQ;
#pragma unroll
    for (int I = 0; I < 4; ++I)
#pragma unroll
      for (int rq = 0; rq < 4; ++rq) {
        const int bq = 32 * I + 8 * rq + 4 * g;
        const int t4 = 128 * a + bq;
        float px[4];
        sconv4(rowx, t4, x0, x1, x2, xb, px);
        const uint2 zv = *(const uint2*)(U + (bt * 64 + a) * 136 + bq);
        const uint2 gv = *(const uint2*)(rowg + t4);
        const float z1[4] = {bflo(zv.x), bfhi(zv.x), bflo(zv.y), bfhi(zv.y)};
        const float gt[4] = {bflo(gv.x), bfhi(gv.x), bflo(gv.y), bfhi(gv.y)};
        float yy[4];
#pragma unroll
        for (int j = 0; j < 4; ++j) yy[j] = px[j] * (acc[I][4 * rq + j] * invn1 + z1[j] * d1) * siluf(gt[j]);
        uint2 ov; ov.x = pack2(yy[0], yy[1]); ov.y = pack2(yy[2], yy[3]);
        *(uint2*)(dst + t4) = ov;
      }
  }
}

DI void phase_mix(int l, char* smem, int lo = 0, int hi = 1024) {
  const P p = load_args();
  for (int it = lo + blockIdx.x; it < hi; it += gridDim.x) {
    __syncthreads();
    if (it < 512) attn_item(p, l, it, smem);
    else hyena_item(p, l, it - 512, smem);
  }
}

DI void phase_final() {
  const P p = load_args();
  const int tid = fresh_tid(), lane = tid & 63, wave = tid >> 6;
  const f32x4* gg = (const f32x4*)p.final_g;
  for (int rp = blockIdx.x * 8 + wave; rp < NTOK / 2; rp += gridDim.x * 8) {
    f32x4 v[2][4];
    f32x4 sq[2][2];
#pragma unroll
    for (int h2 = 0; h2 < 2; ++h2) {
      const int row = 2 * rp + h2;
      sq[h2][0] = ((const f32x4*)(p.ssq + (size_t)row * 8))[0];
      sq[h2][1] = ((const f32x4*)(p.ssq + (size_t)row * 8))[1];
#pragma unroll
      for (int i = 0; i < 4; ++i) {
        const uint2 hv = ((const uint2*)(p.hb + (size_t)row * 1024))[lane + 64 * i];
        f32x4 t; t[0] = bflo(hv.x); t[1] = bfhi(hv.x); t[2] = bflo(hv.y); t[3] = bfhi(hv.y);
        v[h2][i] = t;
      }
    }
#pragma unroll
    for (int h2 = 0; h2 < 2; ++h2) {
      const int row = 2 * rp + h2;
      const float s = sq[h2][0][0] + sq[h2][0][1] + sq[h2][0][2] + sq[h2][0][3] + sq[h2][1][0] + sq[h2][1][1] + sq[h2][1][2] + sq[h2][1][3];
      const float rs = rsqrtf(s * (1.0f / 1024.0f) + 1e-6f);
#pragma unroll
      for (int i = 0; i < 4; ++i) {
        const f32x4 w = gg[lane + 64 * i];
        f32x4 o = v[h2][i];
        o[0] *= rs * w[0]; o[1] *= rs * w[1]; o[2] *= rs * w[2]; o[3] *= rs * w[3];
        ((f32x4*)(p.out + (size_t)row * 1024))[lane + 64 * i] = o;
      }
    }
  }
}

#define XB_TMO      128
#define XB_XCNT(j)  (256  + 64 * (j))
#define XB_XSUB(j)  (1280 + 64 * (j))
#define XB_XGEN(j)  (2304 + 64 * (j))
#define XB_TOP      3328
#define XB_TOPGEN   3392
#define XCD_BAR_WORDS 3456
#define XB_SPIN_CAP (1u << 18)
#define LAS __attribute__((address_space(3)))

__device__ __forceinline__ unsigned xb_ld(unsigned* p)              { return __hip_atomic_load(p, __ATOMIC_RELAXED, __HIP_MEMORY_SCOPE_AGENT); }
__device__ __forceinline__ unsigned xb_add(unsigned* p, unsigned v) { return __hip_atomic_fetch_add(p, v, __ATOMIC_RELAXED, __HIP_MEMORY_SCOPE_AGENT); }
__device__ __forceinline__ unsigned xb_xcc_id() { return (unsigned)__builtin_amdgcn_s_getreg((3 << 11) | 20) & 0xFu; }
#define XB_SPIN(cond, bar) do { unsigned _sp = 0; while (cond) { __builtin_amdgcn_s_sleep(1); \
    if ((++_sp & 255u) == 0u) { if (xb_ld(&(bar)[XB_TMO])) break; if (_sp > XB_SPIN_CAP) { atomicAdd(&(bar)[XB_TMO], 1u); break; } } } } while (0)

struct XcdBarrier {
    unsigned* bar; unsigned x;
    volatile LAS unsigned* st;
};

__device__ __forceinline__ XcdBarrier xcd_barrier_post(unsigned* bar, volatile LAS unsigned* st) {
    XcdBarrier b; b.bar = bar; b.x = xb_xcc_id(); b.st = st;
    if (threadIdx.x == 0) (void)xb_add(&bar[XB_XCNT(b.x)], 1u);
    return b;
}
__device__ __forceinline__ void xcd_barrier_complete(unsigned* bar, unsigned x, unsigned& nloc, unsigned& nx) {
    const unsigned G = gridDim.x * gridDim.y * gridDim.z;
    unsigned sum, cnt, mine, sp = 0u;
    for (;;) {
        sum = 0u; cnt = 0u; mine = 0u;
#pragma unroll
        for (unsigned j = 0; j < 16; ++j) { const unsigned c = xb_ld(&bar[XB_XCNT(j)]); sum += c; cnt += (c > 0u) ? 1u : 0u; mine = (j == x) ? c : mine; }
        if (sum == G) break;
        __builtin_amdgcn_s_sleep(1);
        if ((++sp & 255u) == 0u) { if (xb_ld(&bar[XB_TMO])) break; if (sp > XB_SPIN_CAP) { atomicAdd(&bar[XB_TMO], 1u); break; } }
    }
    nloc = mine > 0u ? mine : 1u; nx = cnt > 0u ? cnt : 1u;
}

__device__ __forceinline__ void xcd_barrier(const XcdBarrier& b) {
    asm volatile("s_waitcnt vmcnt(0)" ::: "memory");
    __syncthreads();
    if (threadIdx.x == 0) {
        unsigned* bar = b.bar;
        __builtin_amdgcn_s_waitcnt(0);
        unsigned nloc = b.st[0], nx = b.st[1];
        if (nloc == 0u) { xcd_barrier_complete(bar, b.x, nloc, nx); b.st[0] = nloc; b.st[1] = nx; }
        const unsigned old = xb_add(&bar[XB_XSUB(b.x)], 1u);
        const unsigned gen = old / nloc;
        if (old + 1u == (gen + 1u) * nloc) {
            __builtin_amdgcn_fence(__ATOMIC_RELEASE, "agent");
            asm volatile("s_waitcnt vmcnt(0)" ::: "memory");
            const unsigned og = xb_add(&bar[XB_TOP], 1u);
            const unsigned tg = og / nx;
            if (og + 1u == (tg + 1u) * nx) xb_add(&bar[XB_TOPGEN], 1u);
            else XB_SPIN(xb_ld(&bar[XB_TOPGEN]) == tg, bar);
            __builtin_amdgcn_fence(__ATOMIC_ACQUIRE, "agent");
            xb_add(&bar[XB_XGEN(b.x)], 1u);
            asm volatile("s_waitcnt vmcnt(0)" ::: "memory");
        } else {
            XB_SPIN(xb_ld(&bar[XB_XGEN(b.x)]) == gen, bar);
            __builtin_amdgcn_fence(__ATOMIC_ACQUIRE, "agent");
            asm volatile("s_waitcnt vmcnt(0)" ::: "memory");
        }
    }
    __syncthreads();
}


#ifndef PH_MASK
#define PH_MASK 31
#endif
#ifndef REP_IN
#define REP_IN 0
#endif
#ifndef REP_FILT
#define REP_FILT 0
#endif
#ifndef REP_ATT
#define REP_ATT 0
#endif
#ifndef REP_HY
#define REP_HY 0
#endif
#ifndef REP_OUT0
#define REP_OUT0 0
#endif
__global__ void __launch_bounds__(NT) mega(P p) {
  extern __shared__ __attribute__((aligned(16))) char smem[];
  cg::grid_group grid = cg::this_grid();
  volatile LAS unsigned* xbw = (volatile LAS unsigned*)(smem + LDS_BYTES - 16);
  if (threadIdx.x < 4) xbw[threadIdx.x] = 0u;
  __syncthreads();
  unsigned* barw;
  { const P pa = load_args(); barw = pa.bar; }
  (void)xcd_barrier_post(barw, xbw);
  phase_prep(smem);
  { XcdBarrier b2; b2.bar = load_args().bar; b2.x = xb_xcc_id(); b2.st = (volatile LAS unsigned*)(smem + LDS_BYTES - 16); xcd_barrier(b2); }
  if (load_args().bar == nullptr) grid.sync();
  for (int l = 0; l < 2; ++l) {
    for (int rep = 0; rep < REP_IN; ++rep) phase_in(l, smem, 0, 1024);
    for (int rep = 0; rep < REP_FILT; ++rep) phase_in(l, smem, 1024, 1280);
    phase_in(l, smem);
    { XcdBarrier b2; b2.bar = load_args().bar; b2.x = xb_xcc_id(); b2.st = (volatile LAS unsigned*)(smem + LDS_BYTES - 16); xcd_barrier(b2); }
    for (int rep = 0; rep < REP_ATT; ++rep) phase_mix(l, smem, 0, 512);
    for (int rep = 0; rep < REP_HY; ++rep) phase_mix(l, smem, 512, 1024);
    phase_mix(l, smem);
    { XcdBarrier b2; b2.bar = load_args().bar; b2.x = xb_xcc_id(); b2.st = (volatile LAS unsigned*)(smem + LDS_BYTES - 16); xcd_barrier(b2); }
    for (int rep = 0; rep < REP_OUT0; ++rep) if (l == 0) phase_out(l, smem);
    phase_out(l, smem);
    { XcdBarrier b2; b2.bar = load_args().bar; b2.x = xb_xcc_id(); b2.st = (volatile LAS unsigned*)(smem + LDS_BYTES - 16); xcd_barrier(b2); }
  }
  phase_final();
}

#if !SINGLE_LAUNCH
__global__ void __launch_bounds__(NT) k_phase(P p, int phase, int l) {
  extern __shared__ __attribute__((aligned(16))) char smem[];
  if (phase == 0) phase_prep(smem);
  else if (phase == 1) phase_in(l, smem);
  else if (phase == 2) phase_mix(l, smem);
  else if (phase == 3) phase_out(l, smem);
  else phase_final();
}
#endif

extern "C" void kernel_launch(void* const* d_in, const int* in_sizes, int n_in, void* d_out, int out_size, void* d_ws,
                              size_t ws_size, hipStream_t stream) {
  P p{};
  const float** fp = (const float**)&p;
  for (int i = 0; i < 21; ++i) fp[i] = (const float*)d_in[i];
  p.out = (float*)d_out;
  char* ws = (char*)d_ws;
  size_t off = 0;
  auto carve = [&](size_t bytes) { char* r = ws + off; off += (bytes + 255) & ~(size_t)255; return r; };
  p.WinT = (u16*)carve((size_t)2 * 4096 * 1024 * 2);
  p.WoutT = (u16*)carve((size_t)2 * 1024 * 1024 * 2);
  p.hb = (u16*)carve((size_t)NTOK * 1024 * 2);
  p.hyT = (u16*)carve((size_t)2048 * HYP * 2);
  p.Qb = (u16*)carve((size_t)NTOK * 512 * 2);
  p.Kb = (u16*)carve((size_t)NTOK * 512 * 2);
  p.VT = (u16*)carve((size_t)1024 * VTP * 2);
  p.AG = (u16*)carve((size_t)NTOK * 512 * 2);
  p.Ya = (u16*)carve((size_t)NTOK * 512 * 2);
  p.YhT = (u16*)carve((size_t)512 * HYP * 2);
  p.Tb = (u16*)carve((size_t)2 * 512 * 16384 * 2);
  p.ssq = (float*)carve((size_t)NTOK * 8 * 4);
  p.npart = (float*)carve((size_t)256 * 2048 * 4);
  p.rope = (float2*)carve((size_t)SEQ * 32 * 8);
  p.kmax = (unsigned*)carve(256);
  p.bar = (unsigned*)carve((size_t)XCD_BAR_WORDS * 4);
  if (off > ws_size) { fprintf(stderr, "workspace too small: need %zu have %zu\n", off, ws_size); return; }

  static int grid_blocks = 0;
  if (!grid_blocks) {
    int dev = 0, cus = 0, per_cu = 0;
    hipGetDevice(&dev);
    hipDeviceGetAttribute(&cus, hipDeviceAttributeMultiprocessorCount, dev);
    hipFuncSetAttribute((const void*)mega, hipFuncAttributeMaxDynamicSharedMemorySize, LDS_BYTES);
#if !SINGLE_LAUNCH
    hipFuncSetAttribute((const void*)k_phase, hipFuncAttributeMaxDynamicSharedMemorySize, LDS_BYTES);
#endif
    hipOccupancyMaxActiveBlocksPerMultiprocessor(&per_cu, mega, NT, LDS_BYTES);
    if (per_cu > 1) per_cu = 1;
    grid_blocks = cus * per_cu;
    if (grid_blocks <= 0) grid_blocks = 256;
  }
#if SINGLE_LAUNCH
  hipMemsetAsync(p.bar, 0, (size_t)XCD_BAR_WORDS * 4, stream);
  void* args[] = {&p};
  hipError_t e = hipLaunchCooperativeKernel((void*)mega, dim3(grid_blocks), dim3(NT), args, LDS_BYTES, stream);
  if (e != hipSuccess) fprintf(stderr, "cooperative launch failed: %s (grid %d)\n", hipGetErrorString(e), grid_blocks);
#else
  k_phase<<<grid_blocks, NT, LDS_BYTES, stream>>>(p, 0, 0);
  for (int l = 0; l < 2; ++l) {
    k_phase<<<grid_blocks, NT, LDS_BYTES, stream>>>(p, 1, l);
    k_phase<<<grid_blocks, NT, LDS_BYTES, stream>>>(p, 2, l);
    k_phase<<<grid_blocks, NT, LDS_BYTES, stream>>>(p, 3, l);
  }
  k_phase<<<grid_blocks, NT, LDS_BYTES, stream>>>(p, 4, 0);
#endif
}
```

```cpp
#include <hip/hip_runtime.h>
#include <hip/hip_cooperative_groups.h>
#include <cstdio>
namespace cg = cooperative_groups;

#ifndef SINGLE_LAUNCH
#define SINGLE_LAUNCH 1
#endif

typedef unsigned short u16;
using bf16x8 = __attribute__((ext_vector_type(8))) short;
using f32x16 = __attribute__((ext_vector_type(16))) float;
using u32x4 = __attribute__((ext_vector_type(4))) unsigned;
using f32x4 = __attribute__((ext_vector_type(4))) float;
typedef __bf16 bf2_t __attribute__((ext_vector_type(2)));
typedef float f2_t __attribute__((ext_vector_type(2)));
#define DI __device__ __forceinline__
DI int fresh_tid() { int t = threadIdx.x; asm volatile("" : "+v"(t)); return t; }
#define MFMA(a, b, c) __builtin_amdgcn_mfma_f32_32x32x16_bf16((a), (b), (c), 0, 0, 0)

constexpr int SEQ = 8192;
constexpr int NTOK = 16384;
constexpr int NT = 512;
constexpr int HYP = NTOK + 64;
constexpr int VTP = SEQ + 64;
constexpr int LDS_BYTES = 149504;

struct P {
  const float *x, *norm_g, *w_in, *conv_w, *conv_b, *fw1, *fb1, *fw2, *fb2, *fw3, *fb3, *ffreq, *fw4, *fbias,
      *lq1, *lk1, *lq2, *lk2, *subg, *w_out, *final_g;
  float* out;
  u16 *WinT, *WoutT, *hb, *hyT, *Qb, *Kb, *VT, *AG, *Ya, *YhT, *Tb;
  float *ssq, *npart;
  float2* rope;
  unsigned* kmax;
  unsigned* bar;
};

DI P load_args() {
#if defined(__HIP_DEVICE_COMPILE__)
  typedef const __attribute__((address_space(4))) P* kargp_t;
  kargp_t pp = (kargp_t)__builtin_amdgcn_kernarg_segment_ptr();
  asm volatile("" : "+s"(pp));
  return *pp;
#else
  return P{};
#endif
}

DI unsigned pack2(float a, float b) {
  f2_t v = {a, b};
  bf2_t r = __builtin_convertvector(v, bf2_t);
  return __builtin_bit_cast(unsigned, r);
}
DI u16 f2bf(float a) { return (u16)(pack2(a, 0.f) & 0xffffu); }
DI float bf2f(unsigned v) { return __uint_as_float(v << 16); }
DI float bflo(unsigned v) { return __uint_as_float(v << 16); }
DI float bfhi(unsigned v) { return __uint_as_float(v & 0xffff0000u); }
DI int crow(int reg, int g) { return (reg & 3) + 8 * (reg >> 2) + 4 * g; }
DI float siluf(float x) { return x * __builtin_amdgcn_rcpf(1.f + __expf(-x)); }
DI f32x16 zero16() { f32x16 z; for (int i = 0; i < 16; ++i) z[i] = 0.f; return z; }

DI void phase_prep(char* smem) {
  const P p = load_args();
  const int tid = threadIdx.x;
  {
    u16* T = (u16*)smem;
    const int kr = tid >> 4, nq = tid & 15;
    const int nr = tid >> 3, kq = tid & 7;
    for (int it = blockIdx.x; it < 2560; it += gridDim.x) {
      const int l = it / 1280, r = it % 1280;
      const float* W; u16* WT; int N; const float* gg; int tile;
      if (r < 1024) { W = p.w_in + (size_t)l * 1024 * 4096; WT = p.WinT + (size_t)l * 4096 * 1024; N = 4096; gg = p.norm_g + l * 1024; tile = r; }
      else { W = p.w_out + (size_t)l * 1024 * 1024; WT = p.WoutT + (size_t)l * 1024 * 1024; N = 1024; gg = nullptr; tile = r - 1024; }
      const int ntn = N / 64;
      const int tn = tile % ntn, tk = tile / ntn;
      const int n0 = tn * 64, k0 = tk * 64;
      const f32x4 va = *(const f32x4*)(W + (size_t)(k0 + kr) * N + n0 + 4 * nq);
      const f32x4 vb = *(const f32x4*)(W + (size_t)(k0 + kr + 32) * N + n0 + 4 * nq);
      const float ga = gg ? gg[k0 + kr] : 1.0f, gb = gg ? gg[k0 + kr + 32] : 1.0f;
      __syncthreads();
#pragma unroll
      for (int j = 0; j < 4; ++j) {
        T[kr * 66 + 4 * nq + j] = f2bf(va[j] * ga);
        T[(kr + 32) * 66 + 4 * nq + j] = f2bf(vb[j] * gb);
      }
      __syncthreads();
      u32x4 o;
#pragma unroll
      for (int j2 = 0; j2 < 4; ++j2)
        o[j2] = (unsigned)T[(8 * kq + 2 * j2) * 66 + nr] | ((unsigned)T[(8 * kq + 2 * j2 + 1) * 66 + nr] << 16);
      *(u32x4*)(WT + (size_t)(n0 + nr) * 1024 + k0 + 8 * kq) = o;
    }
    __syncthreads();
  }
  if (blockIdx.x == 0 && tid < 16) p.kmax[tid] = 0u;
  for (int i = blockIdx.x * NT + tid; i < SEQ * 32; i += gridDim.x * NT) {
    const int pos = i >> 5, j = i & 31;
    const float invf = exp2f(-(float)j * (13.287712379549449f / 32.0f));
    float sn, cs;
    sincosf((float)pos * invf, &sn, &cs);
    p.rope[i] = make_float2(cs, sn);
  }
  {
    const int lane = tid & 63, wave = tid >> 6;
    for (int rp = blockIdx.x * 8 + wave; rp < NTOK / 2; rp += gridDim.x * 8) {
      f32x4 v[2][4];
#pragma unroll
      for (int h2 = 0; h2 < 2; ++h2)
#pragma unroll
        for (int i = 0; i < 4; ++i) v[h2][i] = ((const f32x4*)(p.x + (size_t)(2 * rp + h2) * 1024))[lane + 64 * i];
#pragma unroll
      for (int h2 = 0; h2 < 2; ++h2) {
        const int row = 2 * rp + h2;
        float s = 0.f;
#pragma unroll
        for (int i = 0; i < 4; ++i) {
          const f32x4 w = v[h2][i];
          s += w[0] * w[0] + w[1] * w[1] + w[2] * w[2] + w[3] * w[3];
          uint2 o; o.x = pack2(w[0], w[1]); o.y = pack2(w[2], w[3]);
          *(uint2*)(p.hb + (size_t)row * 1024 + (lane + 64 * i) * 4) = o;
        }
#pragma unroll
        for (int m = 32; m >= 1; m >>= 1) s += __shfl_xor(s, m);
        if (lane < 8) p.ssq[row * 8 + lane] = (lane == 0) ? s : 0.f;
      }
    }
  }
}

DI void filter_tile(const P& p, int l, int tile, char* smem) {
  float* z = (float*)smem;
  float* h1 = z + 32 * 36;
  float* h2 = h1 + 32 * 68;
  u16* h3 = (u16*)(h2 + 32 * 68);
  const int tid = fresh_tid();
  const int m0 = tile * 32;
  for (int idx = tid; idx < 32 * 33; idx += NT) {
    const int pp = idx / 33, e = idx % 33;
    const int m = m0 + pp;
    float val;
    if (e == 0) val = (float)m / 8191.0f;
    else {
      const int j = (e - 1) & 15;
      const float fbj = 1e-4f + (float)j * ((15.0f - 1e-4f) / 15.0f);
      const float wpos = (6.283185307179586f * (float)m) / 8192.0f;
      const float ph = wpos * fbj;
      val = (e <= 16) ? cosf(ph) : -sinf(ph);
    }
    z[pp * 36 + e] = val;
  }
  const int r = tid & 63, pq = tid >> 6;
  const float fr = p.ffreq[l * 64 + r];
  float* Ws = (float*)(h3 + 32 * 72);
  f32x4 wq1[2], wq2[2], wq3[2];
  {
    const f32x4* w1 = (const f32x4*)(p.fw1 + l * 33 * 64);
    const f32x4* w2 = (const f32x4*)(p.fw2 + l * 64 * 64);
    const f32x4* w3 = (const f32x4*)(p.fw3 + l * 64 * 64);
#pragma unroll
    for (int i = 0; i < 2; ++i) { const int q = tid + NT * i; wq1[i] = w1[(q < 528) ? q : 0]; }
#pragma unroll
    for (int i = 0; i < 2; ++i) { wq2[i] = w2[tid + NT * i]; wq3[i] = w3[tid + NT * i]; }
  }
  const float b1v = p.fb1[l * 64 + r], b2v = p.fb2[l * 64 + r], b3v = p.fb3[l * 64 + r];
#pragma unroll
  for (int i = 0; i < 2; ++i) { const int q = tid + NT * i; if (q < 528) ((f32x4*)Ws)[q] = wq1[i]; }
  __syncthreads();
  {
    float s[4];
#pragma unroll
    for (int i = 0; i < 4; ++i) s[i] = b1v;
#pragma unroll 3
    for (int e = 0; e < 33; ++e) {
      const float wv = Ws[e * 64 + r];
#pragma unroll
      for (int i = 0; i < 4; ++i) s[i] += z[(pq + 8 * i) * 36 + e] * wv;
    }
#pragma unroll
    for (int i = 0; i < 4; ++i) h1[(pq + 8 * i) * 68 + r] = sinf(fr * s[i]);
  }
  __syncthreads();
#pragma unroll
  for (int i = 0; i < 2; ++i) ((f32x4*)Ws)[tid + NT * i] = wq2[i];
  __syncthreads();
  {
    float s[4];
#pragma unroll
    for (int i = 0; i < 4; ++i) s[i] = b2v;
#pragma unroll 4
    for (int e = 0; e < 64; ++e) {
      const float wv = Ws[e * 64 + r];
#pragma unroll
      for (int i = 0; i < 4; ++i) s[i] += h1[(pq + 8 * i) * 68 + e] * wv;
    }
#pragma unroll
    for (int i = 0; i < 4; ++i) h2[(pq + 8 * i) * 68 + r] = sinf(fr * s[i]);
  }
  __syncthreads();
#pragma unroll
  for (int i = 0; i < 2; ++i) ((f32x4*)Ws)[tid + NT * i] = wq3[i];
  __syncthreads();
  {
    float s[4];
#pragma unroll
    for (int i = 0; i < 4; ++i) s[i] = b3v;
#pragma unroll 4
    for (int e = 0; e < 64; ++e) {
      const float wv = Ws[e * 64 + r];
#pragma unroll
      for (int i = 0; i < 4; ++i) s[i] += h2[(pq + 8 * i) * 68 + e] * wv;
    }
#pragma unroll
    for (int i = 0; i < 4; ++i) h3[(pq + 8 * i) * 72 + r] = f2bf(sinf(fr * s[i]));
  }
  __syncthreads();
  const int lane = tid & 63, wave = tid >> 6, li = lane & 31, g = lane >> 5;
  bf16x8 af[4];
#pragma unroll
  for (int ks = 0; ks < 4; ++ks) af[ks] = *(const bf16x8*)(h3 + li * 72 + 16 * ks + 8 * g);
  const float* w4 = p.fw4 + (size_t)l * 64 * 2048;
  const float min_decay = -3.0701134573253944f, max_decay = -15.350567286626973f;
  for (int nb = 0; nb < 8; nb += 2) {
    u32x4 bw[2][4];
#pragma unroll
    for (int u = 0; u < 2; ++u) {
      const int col = wave * 256 + (nb + u) * 32 + li;
#pragma unroll
      for (int ks = 0; ks < 4; ++ks) {
        const float* wp = w4 + (size_t)(16 * ks + 8 * g) * 2048 + col;
        const float a0 = wp[0], a1 = wp[2048], a2 = wp[2 * 2048], a3 = wp[3 * 2048];
        const float a4 = wp[4 * 2048], a5 = wp[5 * 2048], a6 = wp[6 * 2048], a7 = wp[7 * 2048];
        u32x4 t; t[0] = pack2(a0, a1); t[1] = pack2(a2, a3); t[2] = pack2(a4, a5); t[3] = pack2(a6, a7);
        bw[u][ks] = t;
      }
    }
#pragma unroll
    for (int u = 0; u < 2; ++u) {
      const int col = wave * 256 + (nb + u) * 32 + li;
      f32x16 acc = zero16();
#pragma unroll
      for (int ks = 0; ks < 4; ++ks) acc = MFMA(af[ks], __builtin_bit_cast(bf16x8, bw[u][ks]), acc);
      const int j = col >> 9, c = col & 511;
      const int order = j & 1;
      const bool fwd = j < 2;
      const float delta = fabsf(min_decay + (float)c * ((max_decay - min_decay) / 511.0f));
      u16* tb = p.Tb + (size_t)(order * 512 + c) * 16384;
      float asum = 0.f;
#pragma unroll
      for (int reg = 0; reg < 16; ++reg) {
        const int m = m0 + crow(reg, g);
        const float t = (float)m / 8191.0f;
        const float v = acc[reg] * __expf(-t * delta);
        if (fwd) { tb[8192 - m] = f2bf(v); asum += fabsf(v); }
        else if (m >= 1) { tb[8192 + m] = f2bf(v); asum += fabsf(v); }
      }
      if (fwd && tile == 0 && g == 0) tb[0] = 0;
      asum += __shfl_xor(asum, 32);
      if (g == 0) p.npart[(size_t)tile * 2048 + col] = asum;
    }
  }
}

template <bool AT>
DI void gemm_main(f32x16 (&acc)[2][4], const u16* __restrict__ R, int ldr, const u16* __restrict__ Cm, int ldc,
                  const u16* __restrict__ RT, int ldrt, int K, char* smem, int tid) {
  constexpr int STG = 2 * 256 * 72;
  u16* S0 = (u16*)smem;
  const int lane = tid & 63, wave = tid >> 6, wr = wave >> 1, wc = wave & 1;
  const int li = lane & 31, g = lane >> 5;
  u32x4 rr[4], cr[4];
#pragma unroll
  for (int a = 0; a < 2; ++a)
#pragma unroll
    for (int b = 0; b < 4; ++b) acc[a][b] = zero16();
  const int nk = K / 64;
#pragma unroll
  for (int i = 0; i < 4; ++i) {
    const int cid = tid + NT * i;
    const int row = cid >> 3, kc = cid & 7;
    if (AT) {
      const int kr = cid >> 5, tc = cid & 31;
      rr[i] = *(const u32x4*)(RT + (size_t)kr * ldrt + tc * 8);
    } else {
      rr[i] = *(const u32x4*)(R + (size_t)row * ldr + kc * 8);
    }
    cr[i] = *(const u32x4*)(Cm + (size_t)row * ldc + kc * 8);
  }
  for (int kt = -1; kt < nk; ++kt) {
    if (kt + 1 < nk) {
      const int ks1 = kt + 1;
      u16* Rs = S0 + (ks1 & 1) * STG;
      u16* Cs = Rs + 256 * 72;
#pragma unroll
      for (int i = 0; i < 4; ++i) {
        const int cid = tid + NT * i;
        const int row = cid >> 3, kc = cid & 7;
        if (AT && ks1 < 8) {
          const int kr = cid >> 5, tc = cid & 31;
          *(u32x4*)(Rs + kr * 264 + tc * 8) = rr[i];
        } else {
          *(u32x4*)(Rs + row * 72 + kc * 8) = rr[i];
        }
        *(u32x4*)(Cs + row * 72 + kc * 8) = cr[i];
      }
    }
    if (kt + 2 < nk) {
      const int kn = kt + 2;
#pragma unroll
      for (int i = 0; i < 4; ++i) {
        const int cid = tid + NT * i;
        const int row = cid >> 3, kc = cid & 7;
        if (AT && kn < 8) {
          const int kr = cid >> 5, tc = cid & 31;
          rr[i] = *(const u32x4*)(RT + (size_t)(kn * 64 + kr) * ldrt + tc * 8);
        } else {
          rr[i] = *(const u32x4*)(R + (size_t)row * ldr + kn * 64 + kc * 8);
        }
        cr[i] = *(const u32x4*)(Cm + (size_t)row * ldc + kn * 64 + kc * 8);
      }
    }
    __builtin_amdgcn_sched_barrier(0);
    if (kt >= 0) {
      const u16* Rs = S0 + (kt & 1) * STG;
      const u16* Cs = Rs + 256 * 72;
      const u16* RTs = Rs;
#pragma unroll
      for (int ks = 0; ks < 4; ++ks) {
        bf16x8 rf[2];
#pragma unroll
        for (int rb = 0; rb < 2; ++rb) {
          if (AT && kt < 8) {
            const u16* src = RTs + (16 * ks + 8 * g) * 264 + 64 * wr + 32 * rb + li;
            bf16x8 t;
#pragma unroll
            for (int j = 0; j < 8; ++j) t[j] = (short)src[j * 264];
            rf[rb] = t;
          } else {
            rf[rb] = *(const bf16x8*)(Rs + (64 * wr + 32 * rb + li) * 72 + 16 * ks + 8 * g);
          }
        }
#pragma unroll
        for (int cb = 0; cb < 4; ++cb) {
          const bf16x8 cfv = *(const bf16x8*)(Cs + (128 * wc + 32 * cb + li) * 72 + 16 * ks + 8 * g);
#pragma unroll
          for (int rb = 0; rb < 2; ++rb) acc[rb][cb] = MFMA(rf[rb], cfv, acc[rb][cb]);
        }
      }
    }
    __syncthreads();
  }
}

template <bool TR>
DI void gemm_in_tile(const P& p, int l, int id, char* smem) {
  const int tid = fresh_tid(), lane = tid & 63, wave = tid >> 6, wr = wave >> 1, wc = wave & 1;
  const int li = lane & 31, g = lane >> 5;
  float* rs_s = (float*)(smem + 147456);
  const int kk = id >> 8, bx = id & 255, xcd = bx & 7, s = bx >> 3;
  const int mt = xcd * 8 + (s & 7), nt = 4 * kk + (s >> 3);
  const int m0 = mt * 256, n0 = nt * 256;
  constexpr bool tr = TR;
  if (tid < 256) {
    const float4* q = (const float4*)(p.ssq + (size_t)(m0 + tid) * 8);
    const float4 a = q[0], b = q[1];
    rs_s[tid] = rsqrtf((a.x + a.y + a.z + a.w + b.x + b.y + b.z + b.w) * (1.0f / 1024.0f) + 1e-6f);
  }
  const u16* A = p.hb + (size_t)m0 * 1024;
  const u16* B = p.WinT + (size_t)l * 4096 * 1024 + (size_t)n0 * 1024;
  f32x16 acc[2][4];
  if (TR) gemm_main<false>(acc, B, 1024, A, 1024, nullptr, 0, 1024, smem, tid);
  else gemm_main<false>(acc, A, 1024, B, 1024, nullptr, 0, 1024, smem, tid);
  if (tr) {
    const bool hy = nt < 8;
#pragma unroll
    for (int cb = 0; cb < 4; ++cb) {
      asm volatile("" ::: "memory");
      const int tl = 128 * wc + 32 * cb + li;
      const int tok = m0 + tl;
      const float rs = rs_s[tl];
      u16* dst = hy ? (p.hyT + (size_t)(n0 + 64 * wr) * HYP + tok)
                    : (p.VT + (size_t)((tok >> 13) * 512 + (n0 - 3072) + 64 * wr) * VTP + (tok & 8191));
      const size_t cstride = hy ? (size_t)HYP : (size_t)VTP;
#pragma unroll
      for (int rb = 0; rb < 2; ++rb) {
#pragma unroll
        for (int reg = 0; reg < 16; ++reg) {
          const int cl = 32 * rb + crow(reg, g);
          dst[(size_t)cl * cstride] = f2bf(acc[rb][cb][reg] * rs);
        }
      }
    }
  } else if (nt < 12) {
    const bool isq = nt < 10;
    const int h = (nt & 1) * 2 + wc;
    u16* dst = isq ? p.Qb : p.Kb;
    const float qs = isq ? (0.125f * 1.4426950408889634f) : 1.0f;
    float kl0 = 0.f, kl1 = 0.f;
#pragma unroll
    for (int rb = 0; rb < 2; ++rb) {
#pragma unroll
      for (int reg = 0; reg < 16; ++reg) {
        if ((reg & 7) == 0) asm volatile("" ::: "memory");
        const int rl = 64 * wr + 32 * rb + crow(reg, g);
        const int tok = m0 + rl;
        const float rs = rs_s[rl] * qs;
        const int pos = tok & 8191, b = tok >> 13;
        const float2 cs = p.rope[pos * 32 + li];
#pragma unroll
        for (int c = 0; c < 2; ++c) {
          const float x1 = acc[rb][2 * c][reg] * rs, x2 = acc[rb][2 * c + 1][reg] * rs;
          const float o1 = x1 * cs.x - x2 * cs.y, o2 = x2 * cs.x + x1 * cs.y;
          const size_t base = ((size_t)(((b * 4 + h) * 2 + c) * SEQ + pos)) * 64;
          dst[base + li] = f2bf(o1);
          dst[base + 32 + li] = f2bf(o2);
          if (c == 0) kl0 = fmaxf(kl0, o1 * o1 + o2 * o2); else kl1 = fmaxf(kl1, o1 * o1 + o2 * o2);
        }
      }
    }
    if (!isq) {
#pragma unroll
      for (int m = 16; m >= 1; m >>= 1) { kl0 += __shfl_xor(kl0, m); kl1 += __shfl_xor(kl1, m); }
      kl0 = fmaxf(kl0, __shfl_xor(kl0, 32)) * 1.02f;
      kl1 = fmaxf(kl1, __shfl_xor(kl1, 32)) * 1.02f;
      if (lane == 0) {
        atomicMax(p.kmax + (m0 >> 13) * 8 + h * 2 + 0, __float_as_uint(kl0));
        atomicMax(p.kmax + (m0 >> 13) * 8 + h * 2 + 1, __float_as_uint(kl1));
      }
    }
  } else {
#pragma unroll
    for (int rb = 0; rb < 2; ++rb) {
#pragma unroll
      for (int reg = 0; reg < 16; ++reg) {
        if ((reg & 7) == 0) asm volatile("" ::: "memory");
        const int rl = 64 * wr + 32 * rb + crow(reg, g);
        const int tok = m0 + rl;
        const float rs = rs_s[rl];
#pragma unroll
        for (int cb = 0; cb < 4; ++cb) {
          const int col = n0 - 3584 + 128 * wc + 32 * cb + li;
          p.AG[(size_t)tok * 512 + col] = f2bf(siluf(acc[rb][cb][reg] * rs));
        }
      }
    }
  }
}

DI void phase_in(int l, char* smem, int lo = 0, int hi = 1024 + 256) {
  const P p = load_args();
  for (int it = lo + blockIdx.x; it < hi; it += gridDim.x) {
    __syncthreads();
    if (it < 1024) {
      const int nt = 4 * (it >> 8) + ((it & 255) >> 6);
      if ((nt < 8) || (nt == 12) || (nt == 13)) gemm_in_tile<true>(p, l, it, smem);
      else gemm_in_tile<false>(p, l, it, smem);
    } else filter_tile(p, l, it - 1024, smem);
  }
}

DI void gemm_out_tile(const P& p, int l, int id, char* smem) {
  const int bx = id & 255, xcd = bx & 7, s = bx >> 3;
  const int mt = xcd * 8 + (s & 7), nt = s >> 3;
  const int m0 = mt * 256, n0 = nt * 256;
  const int tid = fresh_tid(), lane = tid & 63, wave = tid >> 6, wr = wave >> 1, wc = wave & 1;
  const int li = lane & 31, g = lane >> 5;
  f32x16 acc[2][4];
  const u16* R = p.Ya + (size_t)m0 * 512 - 512;
  const u16* Cm = p.WoutT + (size_t)l * 1024 * 1024 + (size_t)n0 * 1024;
  const u16* RT = p.YhT + m0;
  gemm_main<true>(acc, R, 512, Cm, 1024, RT, HYP, 1024, smem, tid);
  __syncthreads();
  float* red = (float*)smem;
#pragma unroll
  for (int rb = 0; rb < 2; ++rb) {
#pragma unroll
    for (int reg = 0; reg < 16; ++reg) {
      const int rl = 64 * wr + 32 * rb + crow(reg, g);
      const int tok = m0 + rl;
      float sacc = 0.f;
#pragma unroll
      for (int cb = 0; cb < 4; ++cb) {
        const int col = n0 + 128 * wc + 32 * cb + li;
        const size_t idx = (size_t)tok * 1024 + col;
        const float hn = bf2f((unsigned)p.hb[idx]) + acc[rb][cb][reg];
        p.hb[idx] = f2bf(hn);
        sacc += hn * hn;
      }
#pragma unroll
      for (int m = 16; m >= 1; m >>= 1) sacc += __shfl_xor(sacc, m);
      if (li == 0) red[wc * 256 + rl] = sacc;
    }
  }
  __syncthreads();
  if (tid < 256) {
    const float v = red[tid] + red[256 + tid];
    p.ssq[(size_t)(m0 + tid) * 8 + 2 * nt] = v;
    p.ssq[(size_t)(m0 + tid) * 8 + 2 * nt + 1] = 0.f;
  }
}

DI void phase_out(int l, char* smem) {
  const P p = load_args();
  for (int it = blockIdx.x; it < 256; it += gridDim.x) {
    __syncthreads();
    gemm_out_tile(p, l, it, smem);
  }
}

DI void attn_item(const P& p, int l, int item, char* smem) {
  u16* Ks = (u16*)smem;
  const int tid = fresh_tid(), lane = tid & 63, wave = tid >> 6;
  const int li = lane & 31, g = lane >> 5;
  const int qg = wave & 3, c = wave >> 2;
  const int bh = item & 7, qb = (item >> 8) * 32 + ((item & 255) >> 3);
  const int b = bh >> 2, h = bh & 3;
  const float lam_init = (l == 0) ? 0.2f : 0.35550906759096926f;
  float lam;
  {
    float s1 = p.lq1[l * 64 + lane] * p.lk1[l * 64 + lane];
    float s2 = p.lq2[l * 64 + lane] * p.lk2[l * 64 + lane];
#pragma unroll
    for (int m = 32; m >= 1; m >>= 1) { s1 += __shfl_xor(s1, m); s2 += __shfl_xor(s2, m); }
    lam = __expf(s1) - __expf(s2) + lam_init;
  }
  const int tq = qb * 128 + qg * 32 + li;
  bf16x8 qf[4];
  float negm;
  {
    float q2 = 0.f;
#pragma unroll
    for (int ks = 0; ks < 4; ++ks) {
      qf[ks] = *(const bf16x8*)(p.Qb + ((size_t)((bh * 2 + c) * SEQ + tq)) * 64 + 16 * ks + 8 * g);
#pragma unroll
      for (int j = 0; j < 8; ++j) { const float v = bf2f((unsigned)(u16)qf[ks][j]); q2 += v * v; }
    }
    q2 += __shfl_xor(q2, 32);
    const float k2 = __uint_as_float(p.kmax[bh * 2 + c]);
    negm = -(sqrtf(q2 * k2) * 1.01f + 1e-3f);
  }
  f32x16 O[4];
#pragma unroll
  for (int eb = 0; eb < 4; ++eb) O[eb] = zero16();
  float ls = 0.f;
  u32x4 kreg[2], vreg[2];
  const u16* kbase = p.Kb + (size_t)(bh * 2) * SEQ * 64;
  const u16* vbase = p.VT + (size_t)(bh * 128) * VTP;
#pragma unroll
  for (int i = 0; i < 2; ++i) kreg[i] = *(const u32x4*)(kbase + ((size_t)i * SEQ) * 64 + tid * 8);
#pragma unroll
  for (int i = 0; i < 2; ++i) {
    const int cid = tid + NT * i;
    const int e = cid >> 3, kc = cid & 7;
    vreg[i] = *(const u32x4*)(vbase + (size_t)e * VTP + kc * 8);
  }
  for (int kt = -1; kt < 128; ++kt) {
    if (kt + 1 < 128) {
      u16* Kd = Ks + ((kt + 1) & 1) * (256 * 72);
      u16* Vd = Kd + 2 * 64 * 72;
#pragma unroll
      for (int i = 0; i < 2; ++i) {
        const int row = tid >> 3, kc = tid & 7;
        *(u32x4*)(Kd + (i * 64 + row) * 72 + kc * 8) = kreg[i];
      }
#pragma unroll
      for (int i = 0; i < 2; ++i) {
        const int cid = tid + NT * i;
        const int e = cid >> 3, kc = cid & 7;
        uint2 w0; w0.x = vreg[i][0]; w0.y = vreg[i][1];
        uint2 w1; w1.x = vreg[i][2]; w1.y = vreg[i][3];
        u16* vd = Vd + e * 72 + (kc >> 1) * 16 + (kc & 1) * 4;
        *(uint2*)vd = w0;
        *(uint2*)(vd + 8) = w1;
      }
    }
    if (kt + 2 < 128) {
      const int kn = kt + 2;
#pragma unroll
      for (int i = 0; i < 2; ++i) kreg[i] = *(const u32x4*)(kbase + ((size_t)i * SEQ + kn * 64) * 64 + tid * 8);
#pragma unroll
      for (int i = 0; i < 2; ++i) {
        const int cid = tid + NT * i;
        const int e = cid >> 3, kc = cid & 7;
        vreg[i] = *(const u32x4*)(vbase + (size_t)e * VTP + kn * 64 + kc * 8);
      }
    }
    __builtin_amdgcn_sched_barrier(0x38F);
    if (kt >= 0) {
      const u16* Kc = Ks + (kt & 1) * (256 * 72);
      const u16* Vc = Kc + 2 * 64 * 72;
      bf16x8 kf[8];
#pragma unroll
      for (int i = 0; i < 8; ++i)
        kf[i] = *(const bf16x8*)(Kc + (c * 64 + 32 * (i & 1) + li) * 72 + 16 * (i >> 1) + 8 * g);
      u32x4 vf[16];
#pragma unroll
      for (int i = 0; i < 16; ++i) {
        const int eb = i & 3, s = (i >> 2) & 1, kb = i >> 3;
        vf[i] = *(const u32x4*)(Vc + (32 * eb + li) * 72 + 32 * kb + 16 * s + 8 * g);
      }
      f32x16 S[2];
#pragma unroll
      for (int kb = 0; kb < 2; ++kb)
#pragma unroll
        for (int r = 0; r < 16; ++r) S[kb][r] = negm;
#pragma unroll
      for (int i = 0; i < 8; ++i) S[i & 1] = MFMA(kf[i], qf[i >> 1], S[i & 1]);
      u32x4 pk[4];
      float sum = 0.f;
#pragma unroll
      for (int ch = 0; ch < 4; ++ch) {
        const int kb = ch >> 1, s = ch & 1;
#pragma unroll
        for (int j2 = 0; j2 < 4; ++j2) {
          const float p0 = __builtin_amdgcn_exp2f(S[kb][8 * s + 2 * j2]);
          const float p1 = __builtin_amdgcn_exp2f(S[kb][8 * s + 2 * j2 + 1]);
          sum += p0 + p1;
          pk[ch][j2] = pack2(p0, p1);
        }
      }
      ls += sum;
#pragma unroll
      for (int i = 0; i < 16; ++i) {
        const int eb = i & 3, ch = i >> 2;
        O[eb] = MFMA(__builtin_bit_cast(bf16x8, vf[i]), __builtin_bit_cast(bf16x8, pk[ch]), O[eb]);
      }
    }
    __syncthreads();
  }
  const float lt = ls + __shfl_xor(ls, 32);
  const float inv = (c == 0) ? (1.0f / lt) : (lam / lt);
  float* exch = (float*)smem + qg * (64 * 64);
  if (c == 1) {
#pragma unroll
    for (int eb = 0; eb < 4; ++eb)
#pragma unroll
      for (int r = 0; r < 16; ++r) exch[(eb * 16 + r) * 64 + lane] = O[eb][r] * inv;
  }
  __syncthreads();
  if (c == 0) {
    float ss = 0.f;
#pragma unroll
    for (int eb = 0; eb < 4; ++eb)
#pragma unroll
      for (int r = 0; r < 16; ++r) {
        const float o = O[eb][r] * inv - exch[(eb * 16 + r) * 64 + lane];
        O[eb][r] = o;
        ss += o * o;
      }
    ss += __shfl_xor(ss, 32);
    const float rn = rsqrtf(ss * (1.0f / 128.0f) + 1e-5f) * (1.0f - lam_init);
    const size_t tok = (size_t)b * SEQ + tq;
#pragma unroll
    for (int eb = 0; eb < 4; ++eb)
#pragma unroll
      for (int rq = 0; rq < 4; ++rq) {
        const int e = 32 * eb + 8 * rq + 4 * g;
        const uint2 gt = *(const uint2*)(p.AG + tok * 512 + h * 128 + e);
        const float4 sg = *(const float4*)(p.subg + l * 128 + e);
        const float o0 = O[eb][4 * rq + 0] * rn * sg.x * bflo(gt.x);
        const float o1 = O[eb][4 * rq + 1] * rn * sg.y * bfhi(gt.x);
        const float o2 = O[eb][4 * rq + 2] * rn * sg.z * bflo(gt.y);
        const float o3 = O[eb][4 * rq + 3] * rn * sg.w * bfhi(gt.y);
        uint2 ov; ov.x = pack2(o0, o1); ov.y = pack2(o2, o3);
        *(uint2*)(p.Ya + tok * 512 + h * 128 + e) = ov;
      }
  }
}

DI void sconv4(const u16* row, int t4, float w0, float w1, float w2, float bias, float (&o)[4]) {
  const uint2 v = *(const uint2*)(row + t4);
  const float x0 = bflo(v.x), x1 = bfhi(v.x), x2 = bflo(v.y), x3 = bfhi(v.y);
  const float xm = (t4 > 0) ? bf2f(row[t4 - 1]) : 0.f;
  const float xp = (t4 + 4 < SEQ) ? bf2f(row[t4 + 4]) : 0.f;
  o[0] = w0 * xm + w1 * x0 + w2 * x1 + bias;
  o[1] = w0 * x0 + w1 * x1 + w2 * x2 + bias;
  o[2] = w0 * x1 + w1 * x2 + w2 * x3 + bias;
  o[3] = w0 * x2 + w1 * x3 + w2 * xp + bias;
}

DI void hy_load_table(const u16* __restrict__ tbg, u16* TbE, u16* TbO, int tid) {
#pragma unroll
  for (int i = 0; i < 4; ++i) {
    const int q = tid + NT * i;
    const uint4 v = *(const uint4*)(tbg + 8 * q);
    const unsigned nxt = (q < 2047) ? (unsigned)tbg[8 * q + 8] : 0u;
    *(uint4*)(TbE + 8 * q) = v;
    uint4 o;
    o.x = (v.x >> 16) | (v.y << 16);
    o.y = (v.y >> 16) | (v.z << 16);
    o.z = (v.z >> 16) | (v.w << 16);
    o.w = (v.w >> 16) | (nxt << 16);
    *(uint4*)(TbO + 8 * q) = o;
  }
}

DI u32x4 hy_afrag(const u16* abase, int f) {
  const unsigned* ap = (const unsigned*)(abase - 16 * f);
  u32x4 r; r[0] = ap[0]; r[1] = ap[1]; r[2] = ap[2]; r[3] = ap[3];
  return r;
}

DI void hy_bfrag(bf16x8 (&bf)[8], const u16* U, const u16* Zrow, int a0, int li, int g, int d) {
  const int ap = a0 + (li & 15) - d;
  const bool valid = (unsigned)ap < 64u;
  const u16* bb = valid ? (U + ((li >> 4) * 64 + ap) * 136 + 8 * g) : (Zrow + 8 * g);
#pragma unroll
  for (int kc = 0; kc < 8; ++kc) bf[kc] = *(const bf16x8*)(bb + 16 * kc);
}

DI void hy_conv(f32x16 (&acc)[4], const u16* abase, const u16* U, const u16* Zrow, int a0, int li, int g) {
#pragma unroll
  for (int i = 0; i < 4; ++i) acc[i] = zero16();
  u32x4 W[14];
  bf16x8 bf[8];
  int d = a0 - 63;
#pragma unroll
  for (int x = 0; x < 14; ++x) W[x] = hy_afrag(abase, 8 * d + x - 7);
  for (; d <= a0 + 15; ++d) {
    hy_bfrag(bf, U, Zrow, a0, li, g, d);
    u32x4 Wn[8];
    const int dn = (d < a0 + 15) ? d + 1 : d;
#pragma unroll
    for (int x = 0; x < 8; ++x) Wn[x] = hy_afrag(abase, 8 * dn + x - 1);
#pragma unroll
    for (int kc = 0; kc < 8; ++kc)
#pragma unroll
      for (int I = 0; I < 4; ++I) acc[I] = MFMA(__builtin_bit_cast(bf16x8, W[2 * I - kc + 7]), bf[kc], acc[I]);
#pragma unroll
    for (int x = 0; x < 6; ++x) W[x] = W[x + 8];
#pragma unroll
    for (int x = 0; x < 8; ++x) W[x + 6] = Wn[x];
  }
}

DI void hyena_item(const P& p, int l, int c, char* smem) {
  u16* TbE = (u16*)smem;
  u16* TbO = TbE + 16384 + 32;
  u16* U = TbO + 16384 + 32;
  u16* Zrow = U + 2 * 64 * 136;
  float* misc = (float*)(Zrow + 136);
  const int tid = fresh_tid(), lane = tid & 63, wave = tid >> 6;
  const int li = lane & 31, g = lane >> 5;
  const int a0 = 16 * (wave & 3);
  const bool cwv = wave < 4;
  const u16* tbg = p.Tb + (size_t)c * 16384;
  {
    const float* np = p.npart + (size_t)(tid & 255) * 2048;
    float v0 = (tid < 256) ? np[c] + np[1024 + c] : 0.f;
    float v1 = (tid < 256) ? np[512 + c] + np[1536 + c] : 0.f;
#pragma unroll
    for (int m = 32; m >= 1; m >>= 1) { v0 += __shfl_xor(v0, m); v1 += __shfl_xor(v1, m); }
    if (lane == 0 && wave < 4) { misc[4 + wave] = v0; misc[8 + wave] = v1; }
  }
  if (tid < 68) ((unsigned*)Zrow)[tid] = 0u;
  hy_load_table(tbg, TbE, TbO, tid);
  const float* cw = p.conv_w + (size_t)l * 3 * 1536;
  const float* cbias = p.conv_b + (size_t)l * 1536;
  {
    const float w0 = cw[c], w1 = cw[1536 + c], w2 = cw[3072 + c], bs = cbias[c];
#pragma unroll
    for (int i = 0; i < 4; ++i) {
      const int q = tid + NT * i;
      const int bt = q >> 10, t8 = (q & 1023) * 8;
      const u16* row = p.hyT + (size_t)c * HYP + bt * SEQ;
      float o0[4], o1[4];
      sconv4(row, t8, w0, w1, w2, bs, o0);
      sconv4(row, t8 + 4, w0, w1, w2, bs, o1);
      uint4 ov;
      ov.x = pack2(o0[0], o0[1]); ov.y = pack2(o0[2], o0[3]); ov.z = pack2(o1[0], o1[1]); ov.w = pack2(o1[2], o1[3]);
      *(uint4*)(U + (bt * 64 + (t8 >> 7)) * 136 + (t8 & 127)) = ov;
    }
  }
  __syncthreads();
  const float invn0 = 1.0f / (misc[4] + misc[5] + misc[6] + misc[7]);
  const float invn1 = 1.0f / (misc[8] + misc[9] + misc[10] + misc[11]);
  const u16* abase = (li & 1) ? (TbO + (8192 - li + 8 * g - 1)) : (TbE + (8192 - li + 8 * g));
  const int bt = li >> 4;
  const int a = a0 + (li & 15);
  f32x16 acc[4];
  if (cwv) hy_conv(acc, abase, U, Zrow, a0, li, g);
  __syncthreads();
  if (cwv) {
    const float d0 = p.fbias[(size_t)(l * 2 + 0) * 512 + c];
    const float v0 = cw[c], v1 = cw[1536 + c], v2 = cw[3072 + c], vb = cbias[c];
    const float x0 = cw[512 + c], x1 = cw[1536 + 512 + c], x2 = cw[3072 + 512 + c], xb = cbias[512 + c];
    const u16* rowv = p.hyT + (size_t)c * HYP + bt * SEQ;
    const u16* rowx = p.hyT + (size_t)(512 + c) * HYP + bt * SEQ;
#pragma unroll
    for (int I = 0; I < 4; ++I)
#pragma unroll
      for (int rq = 0; rq < 4; ++rq) {
        const int bq = 32 * I + 8 * rq + 4 * g;
        const int t4 = 128 * a + bq;
        float pv[4], px[4];
        sconv4(rowv, t4, v0, v1, v2, vb, pv);
        sconv4(rowx, t4, x0, x1, x2, xb, px);
        float zz[4];
#pragma unroll
        for (int j = 0; j < 4; ++j) zz[j] = px[j] * (acc[I][4 * rq + j] * invn0 + pv[j] * d0);
        uint2 ov; ov.x = pack2(zz[0], zz[1]); ov.y = pack2(zz[2], zz[3]);
        *(uint2*)(U + (bt * 64 + a) * 136 + bq) = ov;
      }
  }
  hy_load_table(tbg + (size_t)512 * 16384, TbE, TbO, tid);
  __syncthreads();
  if (cwv) hy_conv(acc, abase, U, Zrow, a0, li, g);
  if (cwv) {
    const float d1 = p.fbias[(size_t)(l * 2 + 1) * 512 + c];
    const float x0 = cw[1024 + c], x1 = cw[1536 + 1024 + c], x2 = cw[3072 + 1024 + c], xb = cbias[1024 + c];
    const u16* rowx = p.hyT + (size_t)(1024 + c) * HYP + bt * SEQ;
    const u16* rowg = p.hyT + (size_t)(1536 + c) * HYP + bt * SEQ;
    u16* dst = p.YhT + (size_t)c * HYP + bt * SEQ;
#pragma unroll
    for (int I = 0; I < 4; ++I)
#pragma unroll
      for (int rq = 0; rq < 4; ++rq) {
        const int bq = 32 * I + 8 * rq + 4 * g;
        const int t4 = 128 * a + bq;
        float px[4];
        sconv4(rowx, t4, x0, x1, x2, xb, px);
        const uint2 zv = *(const uint2*)(U + (bt * 64 + a) * 136 + bq);
        const uint2 gv = *(const uint2*)(rowg + t4);
        const float z1[4] = {bflo(zv.x), bfhi(zv.x), bflo(zv.y), bfhi(zv.y)};
        const float gt[4] = {bflo(gv.x), bfhi(gv.x), bflo(gv.y), bfhi(gv.y)};
        float yy[4];
#pragma unroll
        for (int j = 0; j < 4; ++j) yy[j] = px[j] * (acc[I][4 * rq + j] * invn1 + z1[j] * d1) * siluf(gt[j]);
        uint2 ov; ov.x = pack2(yy[0], yy[1]); ov.y = pack2(yy[2], yy[3]);
        *(uint2*)(dst + t4) = ov;
      }
  }
}

DI void phase_mix(int l, char* smem, int lo = 0, int hi = 1024) {
  const P p = load_args();
  for (int it = lo + blockIdx.x; it < hi; it += gridDim.x) {
    __syncthreads();
    if (it < 512) attn_item(p, l, it, smem);
    else hyena_item(p, l, it - 512, smem);
  }
}

DI void phase_final() {
  const P p = load_args();
  const int tid = fresh_tid(), lane = tid & 63, wave = tid >> 6;
  const f32x4* gg = (const f32x4*)p.final_g;
  for (int rp = blockIdx.x * 8 + wave; rp < NTOK / 2; rp += gridDim.x * 8) {
    f32x4 v[2][4];
    f32x4 sq[2][2];
#pragma unroll
    for (int h2 = 0; h2 < 2; ++h2) {
      const int row = 2 * rp + h2;
      sq[h2][0] = ((const f32x4*)(p.ssq + (size_t)row * 8))[0];
      sq[h2][1] = ((const f32x4*)(p.ssq + (size_t)row * 8))[1];
#pragma unroll
      for (int i = 0; i < 4; ++i) {
        const uint2 hv = ((const uint2*)(p.hb + (size_t)row * 1024))[lane + 64 * i];
        f32x4 t; t[0] = bflo(hv.x); t[1] = bfhi(hv.x); t[2] = bflo(hv.y); t[3] = bfhi(hv.y);
        v[h2][i] = t;
      }
    }
#pragma unroll
    for (int h2 = 0; h2 < 2; ++h2) {
      const int row = 2 * rp + h2;
      const float s = sq[h2][0][0] + sq[h2][0][1] + sq[h2][0][2] + sq[h2][0][3] + sq[h2][1][0] + sq[h2][1][1] + sq[h2][1][2] + sq[h2][1][3];
      const float rs = rsqrtf(s * (1.0f / 1024.0f) + 1e-6f);
#pragma unroll
      for (int i = 0; i < 4; ++i) {
        const f32x4 w = gg[lane + 64 * i];
        f32x4 o = v[h2][i];
        o[0] *= rs * w[0]; o[1] *= rs * w[1]; o[2] *= rs * w[2]; o[3] *= rs * w[3];
        ((f32x4*)(p.out + (size_t)row * 1024))[lane + 64 * i] = o;
      }
    }
  }
}

#define XB_TMO      128
#define XB_XCNT(j)  (256  + 64 * (j))
#define XB_XSUB(j)  (1280 + 64 * (j))
#define XB_XGEN(j)  (2304 + 64 * (j))
#define XB_TOP      3328
#define XB_TOPGEN   3392
#define XCD_BAR_WORDS 3456
#define XB_SPIN_CAP (1u << 18)
#define LAS __attribute__((address_space(3)))

__device__ __forceinline__ unsigned xb_ld(unsigned* p)              { return __hip_atomic_load(p, __ATOMIC_RELAXED, __HIP_MEMORY_SCOPE_AGENT); }
__device__ __forceinline__ unsigned xb_add(unsigned* p, unsigned v) { return __hip_atomic_fetch_add(p, v, __ATOMIC_RELAXED, __HIP_MEMORY_SCOPE_AGENT); }
__device__ __forceinline__ unsigned xb_xcc_id() { return (unsigned)__builtin_amdgcn_s_getreg((3 << 11) | 20) & 0xFu; }
#define XB_SPIN(cond, bar) do { unsigned _sp = 0; while (cond) { __builtin_amdgcn_s_sleep(1); \
    if ((++_sp & 255u) == 0u) { if (xb_ld(&(bar)[XB_TMO])) break; if (_sp > XB_SPIN_CAP) { atomicAdd(&(bar)[XB_TMO], 1u); break; } } } } while (0)

struct XcdBarrier {
    unsigned* bar; unsigned x;
    volatile LAS unsigned* st;
};

__device__ __forceinline__ XcdBarrier xcd_barrier_post(unsigned* bar, volatile LAS unsigned* st) {
    XcdBarrier b; b.bar = bar; b.x = xb_xcc_id(); b.st = st;
    if (threadIdx.x == 0) (void)xb_add(&bar[XB_XCNT(b.x)], 1u);
    return b;
}
__device__ __forceinline__ void xcd_barrier_complete(unsigned* bar, unsigned x, unsigned& nloc, unsigned& nx) {
    const unsigned G = gridDim.x * gridDim.y * gridDim.z;
    unsigned sum, cnt, mine, sp = 0u;
    for (;;) {
        sum = 0u; cnt = 0u; mine = 0u;
#pragma unroll
        for (unsigned j = 0; j < 16; ++j) { const unsigned c = xb_ld(&bar[XB_XCNT(j)]); sum += c; cnt += (c > 0u) ? 1u : 0u; mine = (j == x) ? c : mine; }
        if (sum == G) break;
        __builtin_amdgcn_s_sleep(1);
        if ((++sp & 255u) == 0u) { if (xb_ld(&bar[XB_TMO])) break; if (sp > XB_SPIN_CAP) { atomicAdd(&bar[XB_TMO], 1u); break; } }
    }
    nloc = mine > 0u ? mine : 1u; nx = cnt > 0u ? cnt : 1u;
}

__device__ __forceinline__ void xcd_barrier(const XcdBarrier& b) {
    asm volatile("s_waitcnt vmcnt(0)" ::: "memory");
    __syncthreads();
    if (threadIdx.x == 0) {
        unsigned* bar = b.bar;
        __builtin_amdgcn_s_waitcnt(0);
        unsigned nloc = b.st[0], nx = b.st[1];
        if (nloc == 0u) { xcd_barrier_complete(bar, b.x, nloc, nx); b.st[0] = nloc; b.st[1] = nx; }
        const unsigned old = xb_add(&bar[XB_XSUB(b.x)], 1u);
        const unsigned gen = old / nloc;
        if (old + 1u == (gen + 1u) * nloc) {
            __builtin_amdgcn_fence(__ATOMIC_RELEASE, "agent");
            asm volatile("s_waitcnt vmcnt(0)" ::: "memory");
            const unsigned og = xb_add(&bar[XB_TOP], 1u);
            const unsigned tg = og / nx;
            if (og + 1u == (tg + 1u) * nx) xb_add(&bar[XB_TOPGEN], 1u);
            else XB_SPIN(xb_ld(&bar[XB_TOPGEN]) == tg, bar);
            __builtin_amdgcn_fence(__ATOMIC_ACQUIRE, "agent");
            xb_add(&bar[XB_XGEN(b.x)], 1u);
            asm volatile("s_waitcnt vmcnt(0)" ::: "memory");
        } else {
            XB_SPIN(xb_ld(&bar[XB_XGEN(b.x)]) == gen, bar);
            __builtin_amdgcn_fence(__ATOMIC_ACQUIRE, "agent");
            asm volatile("s_waitcnt vmcnt(0)" ::: "memory");
        }
    }
    __syncthreads();
}


#ifndef PH_MASK
#define PH_MASK 31
#endif
#ifndef REP_IN
#define REP_IN 0
#endif
#ifndef REP_FILT
#define REP_FILT 0
#endif
#ifndef REP_ATT
#define REP_ATT 0
#endif
#ifndef REP_HY
#define REP_HY 0
#endif
#ifndef REP_OUT0
#define REP_OUT0 0
#endif
__global__ void __launch_bounds__(NT) mega(P p) {
  extern __shared__ __attribute__((aligned(16))) char smem[];
  cg::grid_group grid = cg::this_grid();
  volatile LAS unsigned* xbw = (volatile LAS unsigned*)(smem + LDS_BYTES - 16);
  if (threadIdx.x < 4) xbw[threadIdx.x] = 0u;
  __syncthreads();
  unsigned* barw;
  { const P pa = load_args(); barw = pa.bar; }
  (void)xcd_barrier_post(barw, xbw);
  phase_prep(smem);
  { XcdBarrier b2; b2.bar = load_args().bar; b2.x = xb_xcc_id(); b2.st = (volatile LAS unsigned*)(smem + LDS_BYTES - 16); xcd_barrier(b2); }
  if (load_args().bar == nullptr) grid.sync();
  for (int l = 0; l < 2; ++l) {
    for (int rep = 0; rep < REP_IN; ++rep) phase_in(l, smem, 0, 1024);
    for (int rep = 0; rep < REP_FILT; ++rep) phase_in(l, smem, 1024, 1280);
    phase_in(l, smem);
    { XcdBarrier b2; b2.bar = load_args().bar; b2.x = xb_xcc_id(); b2.st = (volatile LAS unsigned*)(smem + LDS_BYTES - 16); xcd_barrier(b2); }
    for (int rep = 0; rep < REP_ATT; ++rep) phase_mix(l, smem, 0, 512);
    for (int rep = 0; rep < REP_HY; ++rep) phase_mix(l, smem, 512, 1024);
    phase_mix(l, smem);
    { XcdBarrier b2; b2.bar = load_args().bar; b2.x = xb_xcc_id(); b2.st = (volatile LAS unsigned*)(smem + LDS_BYTES - 16); xcd_barrier(b2); }
    for (int rep = 0; rep < REP_OUT0; ++rep) if (l == 0) phase_out(l, smem);
    phase_out(l, smem);
    { XcdBarrier b2; b2.bar = load_args().bar; b2.x = xb_xcc_id(); b2.st = (volatile LAS unsigned*)(smem + LDS_BYTES - 16); xcd_barrier(b2); }
  }
  phase_final();
}

#if !SINGLE_LAUNCH
__global__ void __launch_bounds__(NT) k_phase(P p, int phase, int l) {
  extern __shared__ __attribute__((aligned(16))) char smem[];
  if (phase == 0) phase_prep(smem);
  else if (phase == 1) phase_in(l, smem);
  else if (phase == 2) phase_mix(l, smem);
  else if (phase == 3) phase_out(l, smem);
  else phase_final();
}
#endif

extern "C" void kernel_launch(void* const* d_in, const int* in_sizes, int n_in, void* d_out, int out_size, void* d_ws,
                              size_t ws_size, hipStream_t stream) {
  P p{};
  const float** fp = (const float**)&p;
  for (int i = 0; i < 21; ++i) fp[i] = (const float*)d_in[i];
  p.out = (float*)d_out;
  char* ws = (char*)d_ws;
  size_t off = 0;
  auto carve = [&](size_t bytes) { char* r = ws + off; off += (bytes + 255) & ~(size_t)255; return r; };
  p.WinT = (u16*)carve((size_t)2 * 4096 * 1024 * 2);
  p.WoutT = (u16*)carve((size_t)2 * 1024 * 1024 * 2);
  p.hb = (u16*)carve((size_t)NTOK * 1024 * 2);
  p.hyT = (u16*)carve((size_t)2048 * HYP * 2);
  p.Qb = (u16*)carve((size_t)NTOK * 512 * 2);
  p.Kb = (u16*)carve((size_t)NTOK * 512 * 2);
  p.VT = (u16*)carve((size_t)1024 * VTP * 2);
  p.AG = (u16*)carve((size_t)NTOK * 512 * 2);
  p.Ya = (u16*)carve((size_t)NTOK * 512 * 2);
  p.YhT = (u16*)carve((size_t)512 * HYP * 2);
  p.Tb = (u16*)carve((size_t)2 * 512 * 16384 * 2);
  p.ssq = (float*)carve((size_t)NTOK * 8 * 4);
  p.npart = (float*)carve((size_t)256 * 2048 * 4);
  p.rope = (float2*)carve((size_t)SEQ * 32 * 8);
  p.kmax = (unsigned*)carve(256);
  p.bar = (unsigned*)carve((size_t)XCD_BAR_WORDS * 4);
  if (off > ws_size) { fprintf(stderr, "workspace too small: need %zu have %zu\n", off, ws_size); return; }

  static int grid_blocks = 0;
  if (!grid_blocks) {
    int dev = 0, cus = 0, per_cu = 0;
    hipGetDevice(&dev);
    hipDeviceGetAttribute(&cus, hipDeviceAttributeMultiprocessorCount, dev);
    hipFuncSetAttribute((const void*)mega, hipFuncAttributeMaxDynamicSharedMemorySize, LDS_BYTES);
#if !SINGLE_LAUNCH
    hipFuncSetAttribute((const void*)k_phase, hipFuncAttributeMaxDynamicSharedMemorySize, LDS_BYTES);
#endif
    hipOccupancyMaxActiveBlocksPerMultiprocessor(&per_cu, mega, NT, LDS_BYTES);
    if (per_cu > 1) per_cu = 1;
    grid_blocks = cus * per_cu;
    if (grid_blocks <= 0) grid_blocks = 256;
  }
#if SINGLE_LAUNCH
  hipMemsetAsync(p.bar, 0, (size_t)XCD_BAR_WORDS * 4, stream);
  void* args[] = {&p};
  hipError_t e = hipLaunchCooperativeKernel((void*)mega, dim3(grid_blocks), dim3(NT), args, LDS_BYTES, stream);
  if (e != hipSuccess) fprintf(stderr, "cooperative launch failed: %s (grid %d)\n", hipGetErrorString(e), grid_blocks);
#else
  k_phase<<<grid_blocks, NT, LDS_BYTES, stream>>>(p, 0, 0);
  for (int l = 0; l < 2; ++l) {
    k_phase<<<grid_blocks, NT, LDS_BYTES, stream>>>(p, 1, l);
    k_phase<<<grid_blocks, NT, LDS_BYTES, stream>>>(p, 2, l);
    k_phase<<<grid_blocks, NT, LDS_BYTES, stream>>>(p, 3, l);
  }
  k_phase<<<grid_blocks, NT, LDS_BYTES, stream>>>(p, 4, 0);
#endif
}
```
